# Optimizing an MI355X kernel written in HIP

```python
import math
import jax, jax.numpy as jnp
from jax import lax
import numpy as np

D_MODEL = 1024
BATCH = 8
SEQ = 2048
DEPTH = 1

HEAD_DIM = 64
N_HEADS_A = 8
N_HEADS_B = 4
N_HEADS_MEM = 4
W_A = N_HEADS_A * HEAD_DIM
W_B = N_HEADS_B * HEAD_DIM
W_M = N_HEADS_MEM * HEAD_DIM
MIX_WIDTH = W_A + W_B + W_M
DILATED_PATTERNS = ((128, 1), (512, 4), (2048, 16))
N_IDX_HEADS = 8
IDX_DIM = 64
TOPK_MAX = 256
N_MEM = 256
Q_BLOCK = 128
RMS_EPS = 1e-6
SPLIT_SIZES = (W_A, W_A, W_A, W_B, HEAD_DIM, HEAD_DIM, W_M, MIX_WIDTH,
               N_IDX_HEADS * IDX_DIM, IDX_DIM, N_IDX_HEADS)
IN_COLS = W_A * 3 + W_B + 2 * HEAD_DIM + W_M + MIX_WIDTH + N_IDX_HEADS * IDX_DIM + IDX_DIM + N_IDX_HEADS

kernel_name = "hybrid_dilated_dsa_memory_block"


def rms_norm(x, g):
    x32 = x.astype(jnp.float32)
    y = x32 * lax.rsqrt(jnp.mean(x32 * x32, axis=-1, keepdims=True) + RMS_EPS)
    return (y * g.astype(jnp.float32)).astype(x.dtype)


def alibi_slopes(n):
    return 2.0 ** (-8.0 * jnp.arange(1, n + 1, dtype=jnp.float32) / n)


def dilated_band_attention(q, k, v, slopes, window, dilation):
    B, T, H, Dh = q.shape
    band = window // dilation
    n = T // dilation
    nb = -(-n // band)
    n_pad = nb * band

    def to_sub(a):
        a = a.reshape(B, n, dilation, H, Dh).transpose(0, 2, 3, 1, 4)
        a = jnp.pad(a, ((0, 0), (0, 0), (0, 0), (0, n_pad - n), (0, 0)))
        return a.reshape(B, dilation, H, nb, band, Dh)

    def with_prev(a):
        prev = jnp.pad(a, ((0, 0), (0, 0), (0, 0), (1, 0), (0, 0), (0, 0)))[:, :, :, :-1]
        return jnp.concatenate([prev, a], axis=4)

    qs = to_sub(q)
    kb = with_prev(to_sub(k))
    vb = with_prev(to_sub(v))
    s = jnp.einsum('brhnqc,brhnkc->brhnqk', qs, kb).astype(jnp.float32) * (Dh ** -0.5)
    qi = jnp.arange(band)[:, None]
    ki = jnp.arange(2 * band)[None, :]
    dist = band + qi - ki
    blk = jnp.arange(nb)[:, None, None]
    valid = (dist >= 0) & (dist <= band) & (blk * band + ki - band >= 0)
    bias = -slopes[:, None, None, None] * (dist * dilation).astype(jnp.float32)[None, None]
    s = jnp.where(valid, s + bias, -jnp.inf)
    m = jnp.max(s, axis=-1, keepdims=True)
    p = jnp.exp(s - m)
    l = jnp.sum(p, axis=-1, keepdims=True)
    o = jnp.einsum('brhnqk,brhnkc->brhnqc', p.astype(vb.dtype), vb).astype(jnp.float32) / l
    lse = (m + jnp.log(l))[..., 0]
    o = o.reshape(B, dilation, H, n_pad, Dh)[:, :, :, :n].transpose(0, 3, 1, 2, 4).reshape(B, T, H, Dh)
    lse = lse.reshape(B, dilation, H, n_pad)[..., :n].transpose(0, 3, 1, 2).reshape(B, T, H)
    return o, lse


def dilated_mixture_attention(q, k, v, slopes):
    outs, lses = [], []
    for window, dilation in DILATED_PATTERNS:
        o, lse = dilated_band_attention(q, k, v, slopes, window, dilation)
        outs.append(o)
        lses.append(lse)
    wts = jax.nn.softmax(jnp.stack(lses, axis=0), axis=0)
    return jnp.sum(wts[..., None] * jnp.stack(outs, axis=0), axis=0)


def dsa_attention(qB, kB, vB, qI, kI, wI, slopes):
    B, T, H, Dh = qB.shape
    k_sel = min(TOPK_MAX, T // 4)
    nblk = T // Q_BLOCK
    pos = jnp.arange(T)

    def blocks(a):
        return a.reshape(B, nblk, Q_BLOCK, *a.shape[2:]).swapaxes(0, 1)

    def one_block(args):
        qb, qib, wib, tq = args
        logits = jnp.einsum('bqhc,bsc->bqhs', qib, kI).astype(jnp.float32) * (IDX_DIM ** -0.5)
        score = jnp.einsum('bqh,bqhs->bqs', wib.astype(jnp.float32) * (N_IDX_HEADS ** -0.5),
                           jax.nn.relu(logits))
        causal = pos[None, :] <= tq[:, None]
        score = jnp.where(causal, score, -jnp.inf)
        _, idx = lax.top_k(score, k_sel)
        gather = jax.vmap(lambda kv, ii: kv[ii])
        k_g = gather(kB, idx)
        v_g = gather(vB, idx)
        s = jnp.einsum('bqhc,bqkc->bhqk', qb, k_g).astype(jnp.float32) * (Dh ** -0.5)
        dist = (tq[:, None] - idx).astype(jnp.float32)
        s = s - slopes[None, :, None, None] * dist[:, None]
        admissible = (idx <= tq[:, None])[:, None]
        s = jnp.where(admissible, s, -jnp.inf)
        p = jax.nn.softmax(s, axis=-1)
        return jnp.einsum('bhqk,bqkc->bqhc', p.astype(v_g.dtype), v_g)

    out = lax.map(one_block, (blocks(qB), blocks(qI), blocks(wI), pos.reshape(nblk, Q_BLOCK)))
    return out.swapaxes(0, 1).reshape(B, T, H, Dh)


def memory_attention(q, k, v):
    s = jnp.einsum('bthc,bmhc->bhtm', q, k).astype(jnp.float32) * (q.shape[-1] ** -0.5)
    p = jax.nn.softmax(s, axis=-1)
    return jnp.einsum('bhtm,bmhc->bthc', p.astype(v.dtype), v)


def setup_inputs(seed: int = 0) -> dict:
    key = jax.random.key(seed)
    ks = jax.random.split(key, 8)
    f32 = jnp.float32
    x = jax.random.normal(ks[0], (BATCH, SEQ, D_MODEL), f32)
    mem = jax.random.normal(ks[1], (BATCH, N_MEM, D_MODEL), f32)
    g_in = 1.0 + 0.01 * jax.random.normal(ks[2], (DEPTH, D_MODEL), f32)
    g_mem = 1.0 + 0.01 * jax.random.normal(ks[3], (DEPTH, D_MODEL), f32)
    w_in = jax.random.normal(ks[4], (DEPTH, D_MODEL, IN_COLS), f32) * (D_MODEL ** -0.5)
    w_mem_kv = jax.random.normal(ks[5], (DEPTH, D_MODEL, 2 * W_M), f32) * (D_MODEL ** -0.5)
    w_out = jax.random.normal(ks[6], (DEPTH, MIX_WIDTH, D_MODEL), f32) * (MIX_WIDTH ** -0.5)
    g_final = 1.0 + 0.01 * jax.random.normal(ks[7], (D_MODEL,), f32)
    return {"x": x, "mem": mem, "g_in": g_in, "g_mem": g_mem, "w_in": w_in,
            "w_mem_kv": w_mem_kv, "w_out": w_out, "g_final": g_final}


def reference(x, mem, g_in, g_mem, w_in, w_mem_kv, w_out, g_final):
    B, T, _ = x.shape
    split_points = np.cumsum(np.array(SPLIT_SIZES))[:-1].tolist()
    slopes_a = alibi_slopes(N_HEADS_A)
    slopes_b = alibi_slopes(N_HEADS_B)
    for layer in range(DEPTH):
        h = rms_norm(x, g_in[layer])
        proj = h @ w_in[layer]
        qA, kA, vA, qB, kB, vB, qM, gate, qI, kI, wI = jnp.split(proj, split_points, axis=-1)
        qA = qA.reshape(B, T, N_HEADS_A, HEAD_DIM)
        kA = kA.reshape(B, T, N_HEADS_A, HEAD_DIM)
        vA = vA.reshape(B, T, N_HEADS_A, HEAD_DIM)
        qB = qB.reshape(B, T, N_HEADS_B, HEAD_DIM)
        qM = qM.reshape(B, T, N_HEADS_MEM, HEAD_DIM)
        qI = qI.reshape(B, T, N_IDX_HEADS, IDX_DIM)

        mem_n = rms_norm(mem, g_mem[layer])
        kvM = mem_n @ w_mem_kv[layer]
        kM, vM = jnp.split(kvM, 2, axis=-1)
        kM = kM.reshape(B, -1, N_HEADS_MEM, HEAD_DIM)
        vM = vM.reshape(B, -1, N_HEADS_MEM, HEAD_DIM)

        oA = dilated_mixture_attention(qA, kA, vA, slopes_a)
        oB = dsa_attention(qB, kB, vB, qI, kI, wI, slopes_b)
        oM = memory_attention(qM, kM, vM)

        o = jnp.concatenate([oA.astype(x.dtype).reshape(B, T, W_A),
                             oB.astype(x.dtype).reshape(B, T, W_B),
                             oM.astype(x.dtype).reshape(B, T, W_M)], axis=-1)
        o = o * jax.nn.silu(gate)
        x = x + o @ w_out[layer]
    return rms_norm(x, g_final)
```

```cpp
#include <hip/hip_runtime.h>
#include <hip/hip_cooperative_groups.h>
#include <cstdio>
#include <cstdint>
namespace cg = cooperative_groups;
namespace pg8 {
#define PG8_LAS __attribute__((address_space(3)))
typedef unsigned short bf16_t;
typedef short bf16x8 __attribute__((ext_vector_type(8)));
typedef float f32x4 __attribute__((ext_vector_type(4)));
typedef unsigned u32x4 __attribute__((ext_vector_type(4)));
constexpr int BM = 256, BK = 64, HALF = 128, HTB = HALF * BK * 2  , STAGE_BYTES = 8 * HTB, NXCD = 8, WGM = 8;

__host__ __device__ __forceinline__ int lds_byte(int r, int c) { const int st = (r >> 4) * 2 + (c >> 5), rr = r & 15, cc = c & 31, ob = rr * 64 + cc * 2; return st * 1024 + (ob ^ (((ob >> 9) & 1) << 5)); }
__host__ __device__ __forceinline__ void stage_rc(int b, int& R, int& C) { const int st = b / 1024, sb = b % 1024, swz = sb ^ (((sb >> 9) & 1) << 5); R = (st >> 1) * 16 + swz / 64; C = (st & 1) * 32 + (swz % 64) / 2; }
__host__ __device__ __forceinline__ int perm32(int rho) { const int n = rho >> 4, i = rho & 15; return 8 * (i >> 2) + 4 * n + (i & 3); }

struct Unit { int pm, pn; };
struct Gemm { const bf16_t* A; const bf16_t* Bt; int M, N, K; };

struct StaticOrder {
    int nM, nN, nwg, G, c;
    __host__ __device__ void init(int M, int N, int G_, int c_) { nM = M / BM; nN = N / BM; nwg = nM * nN; G = G_; c = c_; }
    __host__ __device__ bool next(int i, Unit& u) const {
        const long L = (long)i * G + c; if (L >= nwg) return false;
        int wgid = (int)L; { const int q = nwg / NXCD, r = nwg % NXCD, xcd = wgid % NXCD, off = wgid / NXCD; wgid = (xcd < r ? xcd * (q + 1) : r * (q + 1) + (xcd - r) * q) + off; }
        const int nig = WGM * nN, gid = wgid / nig, fm = gid * WGM, gsz = (nM - fm) < WGM ? (nM - fm) : WGM;
        u.pm = fm + ((wgid % nig) % gsz); u.pn = (wgid % nig) / gsz; return true;
    }
    __device__ __forceinline__ void a_ready(const Unit&) const {}
    __device__ __forceinline__ void done(const Unit&) const {}
};

__device__ __forceinline__ unsigned cvt_pk_bf16(float lo, float hi) { unsigned r; asm volatile("v_cvt_pk_bf16_f32 %0, %1, %2" : "=v"(r) : "v"(lo), "v"(hi)); return r; }
typedef float f32x2 __attribute__((ext_vector_type(2)));
struct EpiProj {
    static constexpr bool PERM = true, AFTER_DRAIN = false;
    bf16_t* P; bf16_t* KVM;
    __device__ __forceinline__ void operator()(const f32x4 (&acc)[2][2][4][2], const Unit& u, int wr, int wc, int fr, int fq) const {
        int row0 = u.pm * BM + wr * 64 + fr; int colt = u.pn * BM; bf16_t* base = P; int ldc = 3840;
        if (u.pn >= 15) { base = KVM; ldc = 512; colt = (u.pn - 15) * BM; row0 -= 16384; }
        const int col0 = colt + wc * 32 + 8 * fq;
#pragma unroll
        for (int ai = 0; ai < 2; ++ai)
#pragma unroll
            for (int m = 0; m < 4; ++m) { bf16_t* rowp = base + (size_t)(row0 + ai * HALF + m * 16) * ldc + col0;
#pragma unroll
                for (int bj = 0; bj < 2; ++bj) { const f32x4 v0 = acc[ai][bj][m][0], v1 = acc[ai][bj][m][1];
                    u32x4 w; w.x = cvt_pk_bf16(v0[0], v0[1]); w.y = cvt_pk_bf16(v0[2], v0[3]); w.z = cvt_pk_bf16(v1[0], v1[1]); w.w = cvt_pk_bf16(v1[2], v1[3]);
                    *(u32x4*)(rowp + bj * HALF) = w; } }
    }
};
struct EpiRes {
    static constexpr bool PERM = false, AFTER_DRAIN = false;
    const float* x; float* out; float* ss;
    __device__ __forceinline__ void operator()(const f32x4 (&acc)[2][2][4][2], const Unit& u, int wr, int wc, int fr, int fq) const {
        const int col0 = u.pn * BM + wc * 32 + 4 * fq;
#pragma unroll
        for (int ai = 0; ai < 2; ++ai)
#pragma unroll
            for (int m = 0; m < 4; ++m) { const int r = u.pm * BM + ai * HALF + wr * 64 + m * 16 + fr; const size_t off = (size_t)r * 1024 + col0; float q = 0.f;
#pragma unroll
                for (int bj = 0; bj < 2; ++bj)
#pragma unroll
                    for (int n = 0; n < 2; ++n) { const f32x4 xv = *(const f32x4*)(x + off + bj * HALF + n * 16); const f32x4 y = xv + acc[ai][bj][m][n];
                        *(f32x4*)(out + off + bj * HALF + n * 16) = y; q += (y[0] * y[0] + y[1] * y[1]) + (y[2] * y[2] + y[3] * y[3]); }
                q += __shfl_xor(q, 16); q += __shfl_xor(q, 32);
                if (fq == 0) atomicAdd(ss + r, q); }
    }
};
struct ProjOrder {
    StaticOrder so; int G, c;
    __device__ void init(int G_, int c_) { so.init(16384, 3840, G_, c_); G = G_; c = c_; }
    __device__ bool next(int i, Unit& u) const {
        const int L = i * G + c;
        if (L < 960) return so.next(i, u);
        if (L < 976) { const int e = L - 960; u.pm = 64 + (e >> 1); u.pn = 15 + (e & 1); return true; }
        return false;
    }
    __device__ __forceinline__ void a_ready(const Unit&) const {}
    __device__ __forceinline__ void done(const Unit&) const {}
};
template <class Epi, class Sched, bool ALIGN_EPI = false, bool SP2 = false>
__device__ __forceinline__ void gemm_phase(PG8_LAS unsigned char* lds, const Gemm g, const Sched& S, const Epi& E) {
    const int tid = threadIdx.x, wid = __builtin_amdgcn_readfirstlane(tid >> 6), lane = tid & 63, wr = wid >> 2, wc = wid & 3, fr = lane & 15, fq = lane >> 4;
    const int K = g.K, nt = K / BK;
    unsigned voffA[2], voffB[2];
#pragma unroll
    for (int i = 0; i < 2; ++i) { int R, C; stage_rc(tid * 16 + i * 8192, R, C); const int Rb = Epi::PERM ? ((R & ~31) + perm32(R & 31)) : R;
        voffA[i] = (unsigned)(R * K + C) * 2u; voffB[i] = (unsigned)(Rb * K + C) * 2u; }
    const size_t kstep = (size_t)(BK * 2);
    const size_t hstep = (size_t)HALF * K * 2;
    const size_t tstep = 2 * hstep;
    const unsigned ldsw = (unsigned)wid * 1024u;
    const int aoff = lds_byte(wr * 64 + fr, fq * 8), boff = lds_byte(wc * 32 + fr, fq * 8);
#define PG8_SA(b, h) (((b) * 2 + (h)) * HTB)
#define PG8_SB(b, h) ((4 + (b) * 2 + (h)) * HTB)
#define PG8_STAGE(bufoff, gbase, voff) do { _Pragma("unroll") for (int _i = 0; _i < 2; ++_i) \
        __builtin_amdgcn_global_load_lds((const unsigned*)((const char*)(gbase) + (voff)[_i]), (PG8_LAS unsigned*)(lds + (bufoff) + ldsw + _i * 8192), 16, 0, 0); } while (0)
#define PG8_LDA(dst, b, h) do { _Pragma("unroll") for (int m = 0; m < 4; ++m) _Pragma("unroll") for (int k = 0; k < 2; ++k) dst[m][k] = *(const PG8_LAS bf16x8*)(lds + PG8_SA(b, h) + aoff + m * 2048 + k * 1024); } while (0)
#define PG8_LDB(dst, b, h) do { _Pragma("unroll") for (int n = 0; n < 2; ++n) _Pragma("unroll") for (int k = 0; k < 2; ++k) dst[n][k] = *(const PG8_LAS bf16x8*)(lds + PG8_SB(b, h) + boff + n * 2048 + k * 1024); } while (0)
#define PG8_MMA(ai, bj, At, Bt) do { __builtin_amdgcn_s_setprio(1); _Pragma("unroll") for (int m = 0; m < 4; ++m) _Pragma("unroll") for (int n = 0; n < 2; ++n) _Pragma("unroll") for (int k = 0; k < 2; ++k) \
        acc[ai][bj][m][n] = __builtin_amdgcn_mfma_f32_16x16x32_bf16(Bt[n][k], At[m][k], acc[ai][bj][m][n], 0, 0, 0); __builtin_amdgcn_s_setprio(0); } while (0)
#define PG8_WAIT_V(n) asm volatile("s_waitcnt vmcnt(" #n ")" ::: "memory")
#define PG8_WAIT_L(n) asm volatile("s_waitcnt lgkmcnt(" #n ")" ::: "memory")
#define PG8_BAR __builtin_amdgcn_s_barrier()
#define PG8_SCHED __builtin_amdgcn_sched_barrier(0)
    Unit cur, nxt; int ui = 0;
    if (!S.next(0, cur)) return;
    f32x4 acc[2][2][4][2];
#pragma unroll
    for (int a = 0; a < 2; ++a)
#pragma unroll
        for (int b = 0; b < 2; ++b)
#pragma unroll
            for (int m = 0; m < 4; ++m)
#pragma unroll
                for (int n = 0; n < 2; ++n) acc[a][b][m][n] = (f32x4){0.f, 0.f, 0.f, 0.f};
    bf16x8 At[4][2], B0[2][2], B1[2][2];
    const char* cA = (const char*)g.A + (size_t)cur.pm * tstep; const char* cB = (const char*)g.Bt + (size_t)cur.pn * tstep;
    S.a_ready(cur);
    if constexpr (SP2) {
        PG8_STAGE(PG8_SB(0, 0), cB, voffB); PG8_STAGE(PG8_SB(0, 1), cB + hstep, voffB); PG8_STAGE(PG8_SA(0, 0), cA, voffA); PG8_STAGE(PG8_SA(0, 1), cA + hstep, voffA);
        if (wr == 1) PG8_BAR;
        PG8_WAIT_V(2); PG8_BAR;
        PG8_STAGE(PG8_SB(1, 0), cB + kstep, voffB); PG8_STAGE(PG8_SA(1, 0), cA + kstep, voffA); PG8_STAGE(PG8_SB(1, 1), cB + hstep + kstep, voffB);
        PG8_WAIT_V(6); PG8_BAR;
    } else {
        PG8_STAGE(PG8_SB(0, 0), cB, voffB); PG8_STAGE(PG8_SA(0, 0), cA, voffA); PG8_STAGE(PG8_SB(0, 1), cB + hstep, voffB); PG8_STAGE(PG8_SA(0, 1), cA + hstep, voffA);
        if (wr == 1) PG8_BAR;
        PG8_WAIT_V(4); PG8_BAR;
        PG8_STAGE(PG8_SB(1, 0), cB + kstep, voffB); PG8_STAGE(PG8_SA(1, 0), cA + kstep, voffA); PG8_STAGE(PG8_SB(1, 1), cB + hstep + kstep, voffB);
        PG8_WAIT_V(6); PG8_BAR;
    }
    for (;;) {
        const bool has_next = S.next(ui + 1, nxt);
        const char* nA = has_next ? (const char*)g.A + (size_t)nxt.pm * tstep : cA; const char* nB = has_next ? (const char*)g.Bt + (size_t)nxt.pn * tstep : cB;
        for (int t = 0; t < nt; t += 2) {
            const bool last = (t == nt - 2);
            const char* a1 = cA + (size_t)(t + 1) * kstep;
            const char* a2 = last ? nA : cA + (size_t)(t + 2) * kstep; const char* b2 = last ? nB : cB + (size_t)(t + 2) * kstep;
            const char* a3 = a2 + kstep; const char* b3 = b2 + kstep;
            if (last && has_next) S.a_ready(nxt);
            if constexpr (SP2) {
            PG8_LDB(B0, 0, 0); PG8_LDB(B1, 0, 1); PG8_SCHED; PG8_LDA(At, 0, 0); PG8_STAGE(PG8_SA(1, 1), a1 + hstep, voffA);
            PG8_WAIT_V(8); PG8_WAIT_L(0); PG8_BAR; PG8_MMA(0, 0, At, B0); PG8_MMA(0, 1, At, B1); PG8_BAR; PG8_SCHED;
            PG8_LDA(At, 0, 1); PG8_STAGE(PG8_SB(0, 0), b2, voffB); PG8_STAGE(PG8_SB(0, 1), b2 + hstep, voffB); PG8_STAGE(PG8_SA(0, 0), a2, voffA);
            PG8_WAIT_V(8); PG8_WAIT_L(0); PG8_BAR; PG8_MMA(1, 0, At, B0); PG8_MMA(1, 1, At, B1); PG8_BAR; PG8_SCHED;
            PG8_LDB(B0, 1, 0); PG8_LDB(B1, 1, 1); PG8_SCHED; PG8_LDA(At, 1, 0); PG8_STAGE(PG8_SA(0, 1), a2 + hstep, voffA);
            PG8_WAIT_V(8); PG8_WAIT_L(0); PG8_BAR; PG8_MMA(0, 0, At, B0); PG8_MMA(0, 1, At, B1); PG8_BAR; PG8_SCHED;
            PG8_LDA(At, 1, 1); PG8_STAGE(PG8_SB(1, 0), b3, voffB); PG8_STAGE(PG8_SB(1, 1), b3 + hstep, voffB); PG8_STAGE(PG8_SA(1, 0), a3, voffA);
            PG8_WAIT_V(8); PG8_WAIT_L(0); PG8_BAR; PG8_MMA(1, 0, At, B0); PG8_MMA(1, 1, At, B1); PG8_BAR; PG8_SCHED;
            } else {
            PG8_LDB(B0, 0, 0); PG8_SCHED; PG8_LDA(At, 0, 0); PG8_STAGE(PG8_SA(1, 1), a1 + hstep, voffA);
            PG8_WAIT_L(8); PG8_BAR; PG8_WAIT_L(0); PG8_MMA(0, 0, At, B0); PG8_BAR; PG8_SCHED;
            PG8_LDB(B1, 0, 1); PG8_STAGE(PG8_SB(0, 0), b2, voffB);
            PG8_BAR; PG8_WAIT_L(0); PG8_MMA(0, 1, At, B1); PG8_BAR;
            PG8_LDA(At, 0, 1); PG8_STAGE(PG8_SA(0, 0), a2, voffA);
            PG8_BAR; PG8_WAIT_L(0); PG8_MMA(1, 0, At, B0); PG8_BAR; PG8_SCHED;
            PG8_STAGE(PG8_SB(0, 1), b2 + hstep, voffB);
            PG8_WAIT_V(6); PG8_BAR; PG8_MMA(1, 1, At, B1); PG8_BAR;
            PG8_LDB(B0, 1, 0); PG8_SCHED; PG8_LDA(At, 1, 0); PG8_STAGE(PG8_SA(0, 1), a2 + hstep, voffA);
            PG8_WAIT_L(8); PG8_BAR; PG8_WAIT_L(0); PG8_MMA(0, 0, At, B0); PG8_BAR; PG8_SCHED;
            PG8_LDB(B1, 1, 1); PG8_STAGE(PG8_SB(1, 0), b3, voffB);
            PG8_BAR; PG8_WAIT_L(0); PG8_MMA(0, 1, At, B1); PG8_BAR;
            PG8_LDA(At, 1, 1); PG8_STAGE(PG8_SA(1, 0), a3, voffA);
            PG8_BAR; PG8_WAIT_L(0); PG8_MMA(1, 0, At, B0); PG8_BAR; PG8_SCHED;
            PG8_STAGE(PG8_SB(1, 1), b3 + hstep, voffB);
            PG8_WAIT_V(6); PG8_BAR; PG8_MMA(1, 1, At, B1); PG8_BAR;
            }
        }
        if constexpr (ALIGN_EPI) { if (wr == 0) PG8_BAR; }
        if constexpr (!Epi::AFTER_DRAIN) { E(acc, cur, wr, wc, fr, fq); S.done(cur); }
        if (!has_next) break;
#pragma unroll
        for (int a = 0; a < 2; ++a)
#pragma unroll
            for (int b = 0; b < 2; ++b)
#pragma unroll
                for (int m = 0; m < 4; ++m)
#pragma unroll
                    for (int n = 0; n < 2; ++n) acc[a][b][m][n] = (f32x4){0.f, 0.f, 0.f, 0.f};
        cur = nxt; cA = nA; cB = nB; ++ui;
        if constexpr (ALIGN_EPI) { if (wr == 1) PG8_BAR; }
    }
    PG8_WAIT_V(0);
    if constexpr (!ALIGN_EPI) { if (wr == 0) PG8_BAR; }
    PG8_BAR;
    if constexpr (Epi::AFTER_DRAIN) { E.fused(acc, cur, wr, wc, fr, fq, lds, wid, lane); S.done(cur); }
#undef PG8_SA
#undef PG8_SB
#undef PG8_STAGE
#undef PG8_LDA
#undef PG8_LDB
#undef PG8_MMA
#undef PG8_WAIT_V
#undef PG8_WAIT_L
#undef PG8_BAR
#undef PG8_SCHED
}
}

constexpr int NB = 8, SEQ = 2048, DMODEL = 1024, NTOK = NB * SEQ, NMEM = 256, NMEMTOK = NB * NMEM;
constexpr int NPROJ = 3784, NPAD = 3840;
constexpr int C_QA = 0, C_KA = 512, C_VA = 1024, C_QB = 1536, C_KB = 1792, C_VB = 1856, C_QM = 1920, C_GATE = 2176, C_QI = 3200, C_KI = 3712, C_WI = 3776;
constexpr float RMS_EPS = 1e-6f;
constexpr float LOG2E = 1.4426950408889634f;
constexpr float C2 = 0.125f * LOG2E;

constexpr size_t MiB = 1u << 20;
constexpr size_t WS_SS = 0;
constexpr size_t WS_WT = 2 * MiB;
constexpr size_t WS_WOUT = 11 * MiB;
constexpr size_t WS_XN = 16 * MiB;
constexpr size_t WS_OG = 16 * MiB;
constexpr size_t WS_PROJ = 52 * MiB;
constexpr size_t WS_KVM = 172 * MiB;
constexpr size_t WS_MASK = 174 * MiB;
constexpr size_t WS_LSE = 178 * MiB;
constexpr size_t WS_OAP = 180 * MiB;
constexpr size_t WS_END = 228 * MiB;

constexpr int LDS_BYTES = 143360;
constexpr int NWAVES = 8;

typedef unsigned short bf16;
typedef short bf16x8 __attribute__((ext_vector_type(8)));
typedef short s16x4 __attribute__((ext_vector_type(4)));
typedef float f32x4 __attribute__((ext_vector_type(4)));
typedef float f32x16 __attribute__((ext_vector_type(16)));
typedef unsigned u32x4 __attribute__((ext_vector_type(4)));
typedef unsigned u32x2 __attribute__((ext_vector_type(2)));
#define LAS __attribute__((address_space(3)))

__device__ __forceinline__ float bf2f(unsigned short b) { return __uint_as_float(((unsigned)b) << 16); }
__device__ __forceinline__ float bflo(unsigned w) { return __uint_as_float(w << 16); }
__device__ __forceinline__ float bfhi(unsigned w) { return __uint_as_float(w & 0xffff0000u); }
typedef float f32x2_t __attribute__((ext_vector_type(2))); typedef __bf16 bf16x2_t __attribute__((ext_vector_type(2)));
__device__ __forceinline__ unsigned cvtpk(float lo, float hi) { f32x2_t v = {lo, hi}; bf16x2_t b = __builtin_convertvector(v, bf16x2_t); return __builtin_bit_cast(unsigned, b); }
__device__ __forceinline__ float wave_sum(float v) {
#pragma unroll
    for (int o = 1; o < 64; o <<= 1) v += __shfl_xor(v, o);
    return v;
}
__device__ __forceinline__ float silu(float g) { return g * __builtin_amdgcn_rcpf(1.0f + __builtin_amdgcn_exp2f(-g * LOG2E)); }

struct Args { const float* x; const float* mem; const float* g_in; const float* g_mem; const float* w_in; const float* w_mem; const float* w_out; const float* g_final;
              float* out; unsigned char* ws; int ph_lo, ph_hi; };

__device__ __forceinline__ void p0_transpose_item(const float* W, int K, int N, int nblk, bf16* WT, int row_off, LAS float* scr, int item, int lane) {
    const int kb = item / nblk, nb = item % nblk, k0 = 64 * kb, n0 = 32 * nb;
    const int n_in = n0 + (lane & 31);
#pragma unroll 8
    for (int i = 0; i < 32; ++i) { const int kk = 2 * i + (lane >> 5); scr[kk * 33 + (lane & 31)] = (n_in < N) ? W[(size_t)(k0 + kk) * N + n_in] : 0.f; }
    asm volatile("s_waitcnt lgkmcnt(0)" ::: "memory");
    const int c = lane & 7;
#pragma unroll
    for (int j = 0; j < 4; ++j) { const int n = (lane >> 3) + 8 * j; const LAS float* s = scr + (8 * c) * 33 + n;
        u32x4 o; o.x = cvtpk(s[0 * 33], s[1 * 33]); o.y = cvtpk(s[2 * 33], s[3 * 33]); o.z = cvtpk(s[4 * 33], s[5 * 33]); o.w = cvtpk(s[6 * 33], s[7 * 33]);
        *(u32x4*)(WT + (size_t)(row_off + n0 + n) * K + k0 + 8 * c) = o; }
    asm volatile("s_waitcnt lgkmcnt(0)" ::: "memory");
}
__device__ __forceinline__ void rms_row_to_bf16(const float* xrow, const f32x4 (&g)[4], bf16* orow, int lane) {
    const f32x4* xr = (const f32x4*)xrow + lane;
    f32x4 v[4]; float s = 0.f;
#pragma unroll
    for (int j = 0; j < 4; ++j) { v[j] = xr[64 * j]; s += (v[j].x * v[j].x + v[j].y * v[j].y) + (v[j].z * v[j].z + v[j].w * v[j].w); }
    const float r = 1.0f / sqrtf(wave_sum(s) * (1.f / DMODEL) + RMS_EPS);
    u32x2* o8 = (u32x2*)orow + lane;
#pragma unroll
    for (int j = 0; j < 4; ++j) { const f32x4 h = v[j] * r * g[j]; u32x2 w; w.x = cvtpk(h.x, h.y); w.y = cvtpk(h.z, h.w); o8[64 * j] = w; }
}
__device__ __forceinline__ void p0_prologue(const Args& a, LAS unsigned char* lds, int wave, int lane) {
    LAS float* scr = (LAS float*)(lds + wave * 8448);
    const int gw = blockIdx.x * NWAVES + wave, NGW = gridDim.x * NWAVES;
    bf16* WT = (bf16*)(a.ws + WS_WT); bf16* WOUT = (bf16*)(a.ws + WS_WOUT); bf16* XN = (bf16*)(a.ws + WS_XN); float* SS = (float*)(a.ws + WS_SS);
    constexpr int I_IN = 16 * 120, I_MEM = 16 * 16, I_OUT = 16 * 32;
    for (int it = gw; it < I_IN + I_MEM + I_OUT; it += NGW) {
        int r = it;
        if (r < I_IN) { p0_transpose_item(a.w_in, 1024, NPROJ, 120, WT, 0, scr, r, lane); continue; } r -= I_IN;
        if (r < I_MEM) { p0_transpose_item(a.w_mem, 1024, 512, 16, WT, NPAD, scr, r, lane); continue; } r -= I_MEM;
        p0_transpose_item(a.w_out, 1024, 1024, 32, WOUT, 0, scr, r, lane);
    }
    { f32x4 g[4];
#pragma unroll
      for (int j = 0; j < 4; ++j) g[j] = ((const f32x4*)a.g_in)[lane + 64 * j];
      for (int m = gw; m < NTOK; m += NGW) rms_row_to_bf16(a.x + (size_t)m * DMODEL, g, XN + (size_t)m * DMODEL, lane);
#pragma unroll
      for (int j = 0; j < 4; ++j) g[j] = ((const f32x4*)a.g_mem)[lane + 64 * j];
      for (int m = gw; m < NMEMTOK; m += NGW) rms_row_to_bf16(a.mem + (size_t)m * DMODEL, g, XN + (size_t)(NTOK + m) * DMODEL, lane); }
    for (int i = blockIdx.x * 512 + threadIdx.x; i < NTOK; i += gridDim.x * 512) SS[i] = 0.f;
}

__device__ __forceinline__ int crow(int r, int hi) { return (r & 3) + 8 * (r >> 2) + 4 * hi; }
#define MFMA32(a, b, c) __builtin_amdgcn_mfma_f32_32x32x16_bf16(a, b, c, 0, 0, 0)
typedef short v4i16_t __attribute__((ext_vector_type(4)));
__device__ __forceinline__ s16x4 vtr(LAS const unsigned char* p) { return __builtin_bit_cast(s16x4, __builtin_amdgcn_ds_read_tr16_b64_v4i16((LAS v4i16_t*)p)); }

__device__ __forceinline__ void att_load_tile(LAS unsigned char* Ks, LAS unsigned char* Vs, const bf16* Kg, const bf16* Vg, long rstride, int key0, int nkeys, int wid, int lane) {
    { const int key = key0 + lane; u32x4 v = {0u, 0u, 0u, 0u}; if (key >= 0 && key < nkeys) v = *(const u32x4*)(Kg + (long)key * rstride + wid * 8); *(LAS u32x4*)(Ks + wid * 1024 + lane * 16) = v; }
    { const int key = key0 + 16 * (wid & 3) + (lane >> 2); u32x4 v = {0u, 0u, 0u, 0u}; if (key >= 0 && key < nkeys) v = *(const u32x4*)(Vg + (long)key * rstride + (wid >> 2) * 32 + (lane & 3) * 8);
      *(LAS u32x4*)(Vs + wid * 1024 + lane * 16) = v; }
}
__device__ __forceinline__ void att_qkt(f32x16& p0, f32x16& p1, LAS const unsigned char* Ks, const bf16x8 (&qr)[4], int r32, int hi) {
    LAS const unsigned char* kb = Ks + hi * 1024 + r32 * 16;
    const f32x16 z = {0.f, 0.f, 0.f, 0.f, 0.f, 0.f, 0.f, 0.f, 0.f, 0.f, 0.f, 0.f, 0.f, 0.f, 0.f, 0.f};
    p0 = z; p1 = z;
#pragma unroll
    for (int d0 = 0; d0 < 4; ++d0) {
        const bf16x8 b0 = *(LAS const bf16x8*)(kb + d0 * 2048), b1 = *(LAS const bf16x8*)(kb + d0 * 2048 + 512);
        p0 = MFMA32(b0, qr[d0], p0); p1 = MFMA32(b1, qr[d0], p1); }
}
__device__ __forceinline__ float att_rowmax(const f32x16& p0, const f32x16& p1) {
    float a = fmaxf(p0[0], p1[0]);
#pragma unroll
    for (int r = 1; r < 16; ++r) a = fmaxf(a, fmaxf(p0[r], p1[r]));
    auto rr = __builtin_amdgcn_permlane32_swap(__float_as_uint(a), __float_as_uint(a), false, false);
    return fmaxf(__uint_as_float(rr[0]), __uint_as_float(rr[1]));
}
struct AttState { float m, l; f32x16 o[2]; };
__device__ __forceinline__ void att_init(AttState& s) { s.m = -1e30f; s.l = 0.f;
#pragma unroll
    for (int r = 0; r < 16; ++r) { s.o[0][r] = 0.f; s.o[1][r] = 0.f; } }
__device__ __forceinline__ void att_update(AttState& s, f32x16& p0, f32x16& p1, LAS float* wsf, LAS const unsigned char* Vs, int lane, int r32, int hi) {
    const float rm = att_rowmax(p0, p1);
    const float mn = fmaxf(s.m, rm); const float alpha = __builtin_amdgcn_exp2f(s.m - mn); s.m = mn;
    float sum = 0.f;
#pragma unroll
    for (int r = 0; r < 16; ++r) { p0[r] = __builtin_amdgcn_exp2f(p0[r] - mn); p1[r] = __builtin_amdgcn_exp2f(p1[r] - mn); sum += p0[r] + p1[r]; }
    s.l = s.l * alpha + sum;
    if (hi == 0) wsf[r32] = alpha;
    asm volatile("s_waitcnt lgkmcnt(0)" ::: "memory");
#pragma unroll
    for (int r = 0; r < 16; ++r) { const float f = wsf[crow(r, hi)]; s.o[0][r] *= f; s.o[1][r] *= f; }
    u32x4 pw[4];
#pragma unroll
    for (int k = 0; k < 2; ++k) {
        pw[k]     = (u32x4){cvtpk(p0[8 * k + 0], p0[8 * k + 1]), cvtpk(p0[8 * k + 2], p0[8 * k + 3]), cvtpk(p0[8 * k + 4], p0[8 * k + 5]), cvtpk(p0[8 * k + 6], p0[8 * k + 7])};
        pw[2 + k] = (u32x4){cvtpk(p1[8 * k + 0], p1[8 * k + 1]), cvtpk(p1[8 * k + 2], p1[8 * k + 3]), cvtpk(p1[8 * k + 4], p1[8 * k + 5]), cvtpk(p1[8 * k + 6], p1[8 * k + 7])}; }
    LAS const unsigned char* vp = Vs + ((lane >> 4) & 1) * 32 + (lane & 3) * 8 + (4 * hi + ((lane & 15) >> 2)) * 64;
#pragma unroll
    for (int dh = 0; dh < 2; ++dh)
#pragma unroll
        for (int ks = 0; ks < 4; ++ks) {
            const s16x4 lo = vtr(vp + dh * 4096 + ks * 1024), hh = vtr(vp + dh * 4096 + ks * 1024 + 512);
            const bf16x8 vf = (bf16x8){lo[0], lo[1], lo[2], lo[3], hh[0], hh[1], hh[2], hh[3]};
            s.o[dh] = MFMA32(__builtin_bit_cast(bf16x8, pw[ks]), vf, s.o[dh]); }
}
__device__ __forceinline__ float att_finish(AttState& s, float (&rli)[16], LAS float* wsf, int r32, int hi) {
    auto rr = __builtin_amdgcn_permlane32_swap(__float_as_uint(s.l), __float_as_uint(s.l), false, false);
    const float l = __uint_as_float(rr[0]) + __uint_as_float(rr[1]);
    if (hi == 0) wsf[32 + r32] = l;
    asm volatile("s_waitcnt lgkmcnt(0)" ::: "memory");
#pragma unroll
    for (int r = 0; r < 16; ++r) rli[r] = __builtin_amdgcn_rcpf(wsf[32 + crow(r, hi)]);
    return l;
}

constexpr int ATT_K = 0, ATT_V = 8192, ATT_WS = 16384;

__device__ __forceinline__ void attA_unit(const Args& a, LAS unsigned char* lds, int u, int wid, int lane) {
    const int r32 = lane & 31, hi = lane >> 5;
    int p, d, b, h, res, i0, n;
    if (u < 512) { p = 0; d = 1; n = 2048; b = u >> 6; h = (u >> 3) & 7; res = 0; i0 = (u & 7) * 256; }
    else if (u < 1024) { const int v = u - 512; p = 1; d = 4; n = 512; b = v >> 6; h = (v >> 3) & 7; res = (v >> 1) & 3; i0 = (v & 1) * 256; }
    else { const int v = u - 1024; p = 2; d = 16; n = 128; b = v >> 7; h = (v >> 4) & 7; res = v & 15; i0 = 0; }
    const bf16* PROJ = (const bf16*)(a.ws + WS_PROJ);
    const bf16* base = PROJ + (size_t)(b * SEQ + res) * NPAD + h * 64;
    const long rstride = (long)d * NPAD;
    const bf16* Kg = base + C_KA; const bf16* Vg = base + C_VA;
    const int qa = i0 + 32 * wid; const bool active = qa < n;
    const int qi = qa + r32;
    bf16x8 qr[4];
    if (active) {
#pragma unroll
        for (int d0 = 0; d0 < 4; ++d0) qr[d0] = *(const bf16x8*)(base + (long)qi * rstride + C_QA + d0 * 16 + hi * 8);
    } else {
#pragma unroll
        for (int d0 = 0; d0 < 4; ++d0) qr[d0] = (bf16x8){0, 0, 0, 0, 0, 0, 0, 0};
    }
    AttState st; att_init(st);
    LAS float* wsf = (LAS float*)(lds + ATT_WS) + wid * 64;
    const float nb2 = -exp2f(-(float)(h + 1)) * (float)d * LOG2E;
    const int kt_lo = (i0 >= 128) ? (i0 - 128) / 64 : 0; int kt_hi = (i0 + 255) / 64; if (kt_hi > n / 64 - 1) kt_hi = n / 64 - 1;
    for (int kt = kt_lo; kt <= kt_hi; ++kt) {
        __syncthreads();
        att_load_tile(lds + ATT_K, lds + ATT_V, Kg, Vg, rstride, kt * 64, n, wid, lane);
        __syncthreads();
        const bool need = active && (64 * kt <= qa + 31) && (64 * kt + 63 >= qa - 128);
        if (need) {
            f32x16 p0, p1; att_qkt(p0, p1, lds + ATT_K, qr, r32, hi);
            const int qk0 = qi - 64 * kt;
#pragma unroll
            for (int r = 0; r < 16; ++r) { const int d0 = qk0 - crow(r, hi), d1 = d0 - 32;
                p0[r] = ((unsigned)d0 <= 128u) ? p0[r] * C2 + nb2 * (float)d0 : -INFINITY;
                p1[r] = ((unsigned)d1 <= 128u) ? p1[r] * C2 + nb2 * (float)d1 : -INFINITY; }
            att_update(st, p0, p1, wsf, lds + ATT_V, lane, r32, hi);
        }
    }
    if (active) {
        float rli[16]; const float l = att_finish(st, rli, wsf, r32, hi);
        bf16* OAP = (bf16*)(a.ws + WS_OAP) + (size_t)p * NTOK * 512; float* LSE = (float*)(a.ws + WS_LSE) + (size_t)p * NTOK * 8;
        if (hi == 0) LSE[(size_t)(b * SEQ + res + d * qi) * 8 + h] = st.m + __builtin_amdgcn_logf(l);
#pragma unroll
        for (int r = 0; r < 16; ++r) { const int q = qa + crow(r, hi); bf16* orow = OAP + (size_t)(b * SEQ + res + d * q) * 512 + h * 64 + r32;
            orow[0] = (bf16)(cvtpk(st.o[0][r] * rli[r], 0.f) & 0xffffu); orow[32] = (bf16)(cvtpk(st.o[1][r] * rli[r], 0.f) & 0xffffu); }
    }
}

__device__ __forceinline__ void attM_unit(const Args& a, LAS unsigned char* lds, int u, int wid, int lane) {
    const int r32 = lane & 31, hi = lane >> 5;
    const int b = u >> 5, h = (u >> 3) & 3, q0 = (u & 7) * 256;
    const bf16* PROJ = (const bf16*)(a.ws + WS_PROJ); const bf16* KVM = (const bf16*)(a.ws + WS_KVM);
    const bf16* Kg = KVM + (size_t)(b * NMEM) * 512 + h * 64; const bf16* Vg = Kg + 256;
    const int qi = q0 + 32 * wid + r32;
    bf16x8 qr[4];
#pragma unroll
    for (int d0 = 0; d0 < 4; ++d0) qr[d0] = *(const bf16x8*)(PROJ + (size_t)(b * SEQ + qi) * NPAD + C_QM + h * 64 + d0 * 16 + hi * 8);
    AttState st; att_init(st);
    LAS float* wsf = (LAS float*)(lds + ATT_WS) + wid * 64;
    for (int kt = 0; kt < 4; ++kt) {
        __syncthreads();
        att_load_tile(lds + ATT_K, lds + ATT_V, Kg, Vg, 512, kt * 64, NMEM, wid, lane);
        __syncthreads();
        f32x16 p0, p1; att_qkt(p0, p1, lds + ATT_K, qr, r32, hi);
#pragma unroll
        for (int r = 0; r < 16; ++r) { p0[r] *= C2; p1[r] *= C2; }
        att_update(st, p0, p1, wsf, lds + ATT_V, lane, r32, hi);
    }
    float rli[16]; att_finish(st, rli, wsf, r32, hi);
    bf16* OG = (bf16*)(a.ws + WS_OG);
#pragma unroll
    for (int r = 0; r < 16; ++r) { const int q = q0 + 32 * wid + crow(r, hi); const size_t row = (size_t)(b * SEQ + q);
        const bf16* grow = PROJ + row * NPAD + C_GATE + 768 + h * 64 + r32; bf16* orow = OG + row * 1024 + 768 + h * 64 + r32;
        orow[0] = (bf16)(cvtpk(st.o[0][r] * rli[r] * silu(bf2f(grow[0])), 0.f) & 0xffffu); orow[32] = (bf16)(cvtpk(st.o[1][r] * rli[r] * silu(bf2f(grow[32])), 0.f) & 0xffffu); }
}

__device__ __forceinline__ void attB_unit(const Args& a, LAS unsigned char* lds, int u, int wid, int lane) {
    const int r32 = lane & 31, hi = lane >> 5;
    const int b = u >> 5, qb = u & 31, h = wid & 3;
    const bf16* PROJ = (const bf16*)(a.ws + WS_PROJ);
    const bf16* base = PROJ + (size_t)(b * SEQ) * NPAD;
    const bf16* Kg = base + C_KB; const bf16* Vg = base + C_VB;
    const int qa = qb * 64 + 32 * (wid >> 2); const int t = qa + r32;
    bf16x8 qr[4];
#pragma unroll
    for (int d0 = 0; d0 < 4; ++d0) qr[d0] = *(const bf16x8*)(base + (size_t)t * NPAD + C_QB + h * 64 + d0 * 16 + hi * 8);
    const unsigned long long* MASK = (const unsigned long long*)(a.ws + WS_MASK) + (size_t)(b * SEQ + t) * 32;
    AttState st; att_init(st);
    LAS float* wsf = (LAS float*)(lds + ATT_WS) + wid * 64;
    const float nb2 = -exp2f(-2.0f * (float)(h + 1)) * LOG2E;
    for (int kt = 0; kt <= qb; ++kt) {
        __syncthreads();
        att_load_tile(lds + ATT_K, lds + ATT_V, Kg, Vg, NPAD, kt * 64, SEQ, wid, lane);
        const unsigned long long bits = MASK[kt];
        __syncthreads();
        f32x16 p0, p1; att_qkt(p0, p1, lds + ATT_K, qr, r32, hi);
        const int qk0 = t - 64 * kt; const unsigned blo = (unsigned)bits, bhi = (unsigned)(bits >> 32);
#pragma unroll
        for (int r = 0; r < 16; ++r) { const int kv = crow(r, hi); const int d0 = qk0 - kv, d1 = d0 - 32;
            p0[r] = ((blo >> kv) & 1u) ? p0[r] * C2 + nb2 * (float)d0 : -INFINITY;
            p1[r] = ((bhi >> kv) & 1u) ? p1[r] * C2 + nb2 * (float)d1 : -INFINITY; }
        att_update(st, p0, p1, wsf, lds + ATT_V, lane, r32, hi);
    }
    float rli[16]; att_finish(st, rli, wsf, r32, hi);
    bf16* OG = (bf16*)(a.ws + WS_OG);
#pragma unroll
    for (int r = 0; r < 16; ++r) { const int q = qa + crow(r, hi); const size_t row = (size_t)(b * SEQ + q);
        const bf16* grow = PROJ + row * NPAD + C_GATE + 512 + h * 64 + r32; bf16* orow = OG + row * 1024 + 512 + h * 64 + r32;
        orow[0] = (bf16)(cvtpk(st.o[0][r] * rli[r] * silu(bf2f(grow[0])), 0.f) & 0xffffu); orow[32] = (bf16)(cvtpk(st.o[1][r] * rli[r] * silu(bf2f(grow[32])), 0.f) & 0xffffu); }
}

constexpr int IDX_PITCH = 2052;
__device__ __forceinline__ void idx_unit(const Args& a, LAS unsigned char* lds, int u, int wid, int lane) {
    const int b = u >> 7, t0 = (u & 127) * 16; const int fr = lane & 15, fq = lane >> 4;
    LAS float* SC = (LAS float*)lds;
    const bf16* PROJ = (const bf16*)(a.ws + WS_PROJ);
    const bf16* qrow = PROJ + (size_t)(b * SEQ + t0 + fr) * NPAD;
    bf16x8 qf[8][2];
#pragma unroll
    for (int h = 0; h < 8; ++h)
#pragma unroll
        for (int ks = 0; ks < 2; ++ks) qf[h][ks] = *(const bf16x8*)(qrow + C_QI + h * 64 + ks * 32 + fq * 8);
    float wv[8];
    { const u32x4 w = *(const u32x4*)(qrow + C_WI); wv[0] = bflo(w.x); wv[1] = bfhi(w.x); wv[2] = bflo(w.y); wv[3] = bfhi(w.y); wv[4] = bflo(w.z); wv[5] = bfhi(w.z); wv[6] = bflo(w.w); wv[7] = bfhi(w.w); }
    const int ntiles = t0 / 16 + 1;
    __syncthreads();
    for (int kt = wid; kt < ntiles; kt += 8) {
        const bf16* krow = PROJ + (size_t)(b * SEQ + kt * 16 + fr) * NPAD + C_KI + fq * 8;
        const bf16x8 k0 = *(const bf16x8*)krow, k1 = *(const bf16x8*)(krow + 32);
        f32x4 sc = {0.f, 0.f, 0.f, 0.f};
#pragma unroll
        for (int h = 0; h < 8; ++h) { f32x4 acc = {0.f, 0.f, 0.f, 0.f};
            acc = __builtin_amdgcn_mfma_f32_16x16x32_bf16(k0, qf[h][0], acc, 0, 0, 0); acc = __builtin_amdgcn_mfma_f32_16x16x32_bf16(k1, qf[h][1], acc, 0, 0, 0);
#pragma unroll
            for (int i = 0; i < 4; ++i) sc[i] += wv[h] * fmaxf(acc[i], 0.f); }
        *(LAS f32x4*)(SC + fr * IDX_PITCH + kt * 16 + fq * 4) = sc;
    }
    __syncthreads();
    unsigned long long* MASK = (unsigned long long*)(a.ws + WS_MASK);
#pragma unroll 1
    for (int rr = 2 * wid; rr < 2 * wid + 2; ++rr) {
        const int t = t0 + rr;
        unsigned uu[32];
#pragma unroll
        for (int j = 0; j < 32; ++j) { const int key = 64 * j + lane; const unsigned bits = __float_as_uint(SC[rr * IDX_PITCH + key]);
            const unsigned s = bits ^ ((bits & 0x80000000u) ? 0xffffffffu : 0x80000000u); uu[j] = (key <= t) ? s : 0u; }
        unsigned tau = 1u;
        if (t >= 256) {
            tau = 0u;
#pragma unroll 1
            for (int bit = 31; bit >= 0; --bit) {
                const unsigned cand = tau | (1u << bit); int c = 0;
#pragma unroll
                for (int j = 0; j < 32; ++j) c += __builtin_popcountll(__ballot(uu[j] >= cand));
                if (c >= 256) tau = cand;
                if (c == 256) break;
            }
        }
        int cgt = 0;
#pragma unroll
        for (int j = 0; j < 32; ++j) cgt += __builtin_popcountll(__ballot(uu[j] > tau));
        const int need = 256 - cgt;
        int base = 0; unsigned long long mine = 0ull;
        const unsigned long long lt = (1ull << lane) - 1ull;
#pragma unroll
        for (int j = 0; j < 32; ++j) {
            const bool eq = (uu[j] == tau) && (uu[j] != 0u); const unsigned long long be = __ballot(eq);
            const int rank = base + __builtin_popcountll(be & lt);
            const bool sel = (uu[j] > tau) || (eq && rank < need);
            const unsigned long long bm = __ballot(sel);
            base += __builtin_popcountll(be);
            if (lane == j) mine = bm;
        }
        if (lane < 32) MASK[(size_t)(b * SEQ + t) * 32 + lane] = mine;
    }
}

__device__ __forceinline__ void merge_rows(const Args& a, int wave, int lane) {
    const int gw = blockIdx.x * NWAVES + wave, NGW = gridDim.x * NWAVES;
    const bf16* PROJ = (const bf16*)(a.ws + WS_PROJ); const bf16* OAP = (const bf16*)(a.ws + WS_OAP); const float* LSE = (const float*)(a.ws + WS_LSE); bf16* OG = (bf16*)(a.ws + WS_OG);
    const int h = lane >> 3, dof = (lane & 7) * 8;
    for (int tok = gw; tok < NTOK; tok += NGW) {
        const float l0 = LSE[(size_t)tok * 8 + h], l1 = LSE[(size_t)(NTOK + tok) * 8 + h], l2 = LSE[(size_t)(2 * NTOK + tok) * 8 + h];
        const float mx = fmaxf(l0, fmaxf(l1, l2));
        float w0 = __builtin_amdgcn_exp2f(l0 - mx), w1 = __builtin_amdgcn_exp2f(l1 - mx), w2 = __builtin_amdgcn_exp2f(l2 - mx);
        const float inv = 1.0f / (w0 + w1 + w2); w0 *= inv; w1 *= inv; w2 *= inv;
        const u32x4 o0 = *(const u32x4*)(OAP + (size_t)tok * 512 + h * 64 + dof), o1 = *(const u32x4*)(OAP + (size_t)(NTOK + tok) * 512 + h * 64 + dof), o2 = *(const u32x4*)(OAP + (size_t)(2 * NTOK + tok) * 512 + h * 64 + dof);
        const u32x4 g = *(const u32x4*)(PROJ + (size_t)tok * NPAD + C_GATE + h * 64 + dof);
        u32x4 res;
#pragma unroll
        for (int i = 0; i < 4; ++i) {
            const float lo = (w0 * bflo(o0[i]) + w1 * bflo(o1[i]) + w2 * bflo(o2[i])) * silu(bflo(g[i]));
            const float hi = (w0 * bfhi(o0[i]) + w1 * bfhi(o1[i]) + w2 * bfhi(o2[i])) * silu(bfhi(g[i]));
            res[i] = cvtpk(lo, hi); }
        *(u32x4*)(OG + (size_t)tok * 1024 + h * 64 + dof) = res;
    }
}

__device__ __forceinline__ void final_norm(const Args& a, int wave, int lane) {
    const int gw = blockIdx.x * NWAVES + wave, NGW = gridDim.x * NWAVES;
    const float* SS = (const float*)(a.ws + WS_SS);
    f32x4 g[4];
#pragma unroll
    for (int j = 0; j < 4; ++j) g[j] = ((const f32x4*)a.g_final)[lane + 64 * j];
    for (int m = gw; m < NTOK; m += NGW) {
        const float r = 1.0f / sqrtf(SS[m] * (1.f / DMODEL) + RMS_EPS);
        f32x4* row = (f32x4*)(a.out + (size_t)m * DMODEL) + lane;
#pragma unroll
        for (int j = 0; j < 4; ++j) row[64 * j] = row[64 * j] * r * g[j];
    }
}

__global__ void __launch_bounds__(NWAVES * 64, 2) fwd_kernel(Args a) {
    extern __shared__ __attribute__((aligned(16))) unsigned char smem[];
    LAS unsigned char* lds = (LAS unsigned char*)smem;
    cg::grid_group grid = cg::this_grid();
    const int tid = threadIdx.x, lane = tid & 63, wave = __builtin_amdgcn_readfirstlane(tid >> 6);
    const int lo = a.ph_lo, hi = a.ph_hi;
#define IN(k) (lo <= (k) && (k) < hi)
#define SEAM(k) do { if (IN(k) && IN((k) + 1)) { asm volatile("s_waitcnt vmcnt(0)" ::: "memory"); grid.sync(); } } while (0)
    if (IN(0)) { p0_prologue(a, lds, wave, lane); }
    SEAM(0);
    if (IN(1)) {
        pg8::Gemm g{(const pg8::bf16_t*)(a.ws + WS_XN), (const pg8::bf16_t*)(a.ws + WS_WT), NTOK + NMEMTOK, NPAD + 512, 1024};
        pg8::ProjOrder S; S.init((int)gridDim.x, (int)blockIdx.x);
        pg8::EpiProj E{(pg8::bf16_t*)(a.ws + WS_PROJ), (pg8::bf16_t*)(a.ws + WS_KVM)};
        pg8::gemm_phase<pg8::EpiProj, pg8::ProjOrder, true, true>(lds, g, S, E);
    }
    SEAM(1);
    if (IN(2)) {
        for (int it = blockIdx.x; it < 1024 + 2048 + 256; it += gridDim.x) {
            if (it < 1024) { const int j = it >> 3, b = it & 7; idx_unit(a, lds, b * 128 + (127 - j), wave, lane); }
            else if (it < 1024 + 2048) { __syncthreads(); attA_unit(a, lds, it - 1024, wave, lane); }
            else { __syncthreads(); attM_unit(a, lds, it - 3072, wave, lane); }
        }
    }
    SEAM(2);
    if (IN(3)) {
        for (int it = blockIdx.x; it < 256; it += gridDim.x) { const int j = it >> 3, b = it & 7; attB_unit(a, lds, b * 32 + (31 - j), wave, lane); }
        merge_rows(a, wave, lane);
    }
    SEAM(3);
    if (IN(4)) {
        pg8::Gemm g{(const pg8::bf16_t*)(a.ws + WS_OG), (const pg8::bf16_t*)(a.ws + WS_WOUT), NTOK, 1024, 1024};
        pg8::StaticOrder S; S.init(NTOK, 1024, (int)gridDim.x, (int)blockIdx.x);
        pg8::EpiRes E{a.x, a.out, (float*)(a.ws + WS_SS)};
        pg8::gemm_phase<pg8::EpiRes, pg8::StaticOrder, true, true>(lds, g, S, E);
    }
    SEAM(4);
    if (IN(5)) { final_norm(a, wave, lane); }
#undef IN
#undef SEAM
}

#ifndef N_LAUNCHES
#define N_LAUNCHES 1
#endif
extern "C" void kernel_launch(void* const* d_in, const int* in_sizes, int n_in, void* d_out, int out_size, void* d_ws, size_t ws_size, hipStream_t stream) {
    static int grid = 0;
    if (grid == 0) {
        if (n_in != 8 || out_size != NTOK * DMODEL || ws_size < WS_END) { fprintf(stderr, "kernel_launch: unexpected shapes (n_in %d out %d ws %zu)\n", n_in, out_size, ws_size); grid = -1; return; }
        int dev = 0, cus = 0, per_cu = 0;
        hipGetDevice(&dev); hipDeviceGetAttribute(&cus, hipDeviceAttributeMultiprocessorCount, dev);
        if (hipFuncSetAttribute((const void*)fwd_kernel, hipFuncAttributeMaxDynamicSharedMemorySize, LDS_BYTES) != hipSuccess) { fprintf(stderr, "kernel_launch: hipFuncSetAttribute failed\n"); grid = -1; return; }
        if (hipOccupancyMaxActiveBlocksPerMultiprocessor(&per_cu, (const void*)fwd_kernel, NWAVES * 64, LDS_BYTES) != hipSuccess || per_cu < 1) { fprintf(stderr, "kernel_launch: occupancy query says %d\n", per_cu); (void)hipGetLastError(); grid = -1; return; }
        grid = cus;
    }
    if (grid < 0) return;
    Args a{};
    a.x = (const float*)d_in[0]; a.mem = (const float*)d_in[1]; a.g_in = (const float*)d_in[2]; a.g_mem = (const float*)d_in[3]; a.w_in = (const float*)d_in[4];
    a.w_mem = (const float*)d_in[5]; a.w_out = (const float*)d_in[6]; a.g_final = (const float*)d_in[7]; a.out = (float*)d_out; a.ws = (unsigned char*)d_ws;
    constexpr int NPH = 6;
    for (int li = 0; li < N_LAUNCHES; ++li) {
        a.ph_lo = (N_LAUNCHES == 1) ? 0 : li; a.ph_hi = (N_LAUNCHES == 1) ? NPH : li + 1;
        void* args[] = {&a};
        hipError_t e = hipLaunchCooperativeKernel((const void*)fwd_kernel, dim3(grid), dim3(NWAVES * 64), args, LDS_BYTES, stream);
        if (e != hipSuccess) { fprintf(stderr, "cooperative launch failed: %s (grid %d)\n", hipGetErrorString(e), grid); break; }
    }
}
```

```cpp
#include <hip/hip_runtime.h>
#include <hip/hip_cooperative_groups.h>
#include <cstdio>
#include <cstdint>
namespace cg = cooperative_groups;
namespace pg8 {
#define PG8_LAS __attribute__((address_space(3)))
typedef unsigned short bf16_t;
typedef short bf16x8 __attribute__((ext_vector_type(8)));
typedef float f32x4 __attribute__((ext_vector_type(4)));
typedef unsigned u32x4 __attribute__((ext_vector_type(4)));
constexpr int BM = 256, BK = 64, HALF = 128, HTB = HALF * BK * 2  , STAGE_BYTES = 8 * HTB, NXCD = 8, WGM = 8;

__host__ __device__ __forceinline__ int lds_byte(int r, int c) { const int st = (r >> 4) * 2 + (c >> 5), rr = r & 15, cc = c & 31, ob = rr * 64 + cc * 2; return st * 1024 + (ob ^ (((ob >> 9) & 1) << 5)); }
__host__ __device__ __forceinline__ void stage_rc(int b, int& R, int& C) { const int st = b / 1024, sb = b % 1024, swz = sb ^ (((sb >> 9) & 1) << 5); R = (st >> 1) * 16 + swz / 64; C = (st & 1) * 32 + (swz % 64) / 2; }
__host__ __device__ __forceinline__ int perm32(int rho) { const int n = rho >> 4, i = rho & 15; return 8 * (i >> 2) + 4 * n + (i & 3); }

struct Unit { int pm, pn; };
struct Gemm { const bf16_t* A; const bf16_t* Bt; int M, N, K; };

struct StaticOrder {
    int nM, nN, nwg, G, c;
    __host__ __device__ void init(int M, int N, int G_, int c_) { nM = M / BM; nN = N / BM; nwg = nM * nN; G = G_; c = c_; }
    __host__ __device__ bool next(int i, Unit& u) const {
        const long L = (long)i * G + c; if (L >= nwg) return false;
        int wgid = (int)L; { const int q = nwg / NXCD, r = nwg % NXCD, xcd = wgid % NXCD, off = wgid / NXCD; wgid = (xcd < r ? xcd * (q + 1) : r * (q + 1) + (xcd - r) * q) + off; }
        const int nig = WGM * nN, gid = wgid / nig, fm = gid * WGM, gsz = (nM - fm) < WGM ? (nM - fm) : WGM;
        u.pm = fm + ((wgid % nig) % gsz); u.pn = (wgid % nig) / gsz; return true;
    }
    __device__ __forceinline__ void a_ready(const Unit&) const {}
    __device__ __forceinline__ void done(const Unit&) const {}
};

__device__ __forceinline__ unsigned cvt_pk_bf16(float lo, float hi) { unsigned r; asm volatile("v_cvt_pk_bf16_f32 %0, %1, %2" : "=v"(r) : "v"(lo), "v"(hi)); return r; }
typedef float f32x2 __attribute__((ext_vector_type(2)));
struct EpiProj {
    static constexpr bool PERM = true, AFTER_DRAIN = false;
    bf16_t* P; bf16_t* KVM;
    __device__ __forceinline__ void operator()(const f32x4 (&acc)[2][2][4][2], const Unit& u, int wr, int wc, int fr, int fq) const {
        int row0 = u.pm * BM + wr * 64 + fr; int colt = u.pn * BM; bf16_t* base = P; int ldc = 3840;
        if (u.pn >= 15) { base = KVM; ldc = 512; colt = (u.pn - 15) * BM; row0 -= 16384; }
        const int col0 = colt + wc * 32 + 8 * fq;
#pragma unroll
        for (int ai = 0; ai < 2; ++ai)
#pragma unroll
            for (int m = 0; m < 4; ++m) { bf16_t* rowp = base + (size_t)(row0 + ai * HALF + m * 16) * ldc + col0;
#pragma unroll
                for (int bj = 0; bj < 2; ++bj) { const f32x4 v0 = acc[ai][bj][m][0], v1 = acc[ai][bj][m][1];
                    u32x4 w; w.x = cvt_pk_bf16(v0[0], v0[1]); w.y = cvt_pk_bf16(v0[2], v0[3]); w.z = cvt_pk_bf16(v1[0], v1[1]); w.w = cvt_pk_bf16(v1[2], v1[3]);
                    *(u32x4*)(rowp + bj * HALF) = w; } }
    }
};
struct EpiRes {
    static constexpr bool PERM = false, AFTER_DRAIN = false;
    const float* x; float* out; float* ss;
    __device__ __forceinline__ void operator()(const f32x4 (&acc)[2][2][4][2], const Unit& u, int wr, int wc, int fr, int fq) const {
        const int col0 = u.pn * BM + wc * 32 + 4 * fq;
#pragma unroll
        for (int ai = 0; ai < 2; ++ai)
#pragma unroll
            for (int m = 0; m < 4; ++m) { const int r = u.pm * BM + ai * HALF + wr * 64 + m * 16 + fr; const size_t off = (size_t)r * 1024 + col0; float q = 0.f;
#pragma unroll
                for (int bj = 0; bj < 2; ++bj)
#pragma unroll
                    for (int n = 0; n < 2; ++n) { const f32x4 xv = *(const f32x4*)(x + off + bj * HALF + n * 16); const f32x4 y = xv + acc[ai][bj][m][n];
                        *(f32x4*)(out + off + bj * HALF + n * 16) = y; q += (y[0] * y[0] + y[1] * y[1]) + (y[2] * y[2] + y[3] * y[3]); }
                q += __shfl_xor(q, 16); q += __shfl_xor(q, 32);
                if (fq == 0) atomicAdd(ss + r, q); }
    }
};
struct ProjOrder {
    StaticOrder so; int G, c;
    __device__ void init(int G_, int c_) { so.init(16384, 3840, G_, c_); G = G_; c = c_; }
    __device__ bool next(int i, Unit& u) const {
        const int L = i * G + c;
        if (L < 960) return so.next(i, u);
        if (L < 976) { const int e = L - 960; u.pm = 64 + (e >> 1); u.pn = 15 + (e & 1); return true; }
        return false;
    }
    __device__ __forceinline__ void a_ready(const Unit&) const {}
    __device__ __forceinline__ void done(const Unit&) const {}
};
template <class Epi, class Sched, bool ALIGN_EPI = false, bool SP2 = false>
__device__ __forceinline__ void gemm_phase(PG8_LAS unsigned char* lds, const Gemm g, const Sched& S, const Epi& E) {
    const int tid = threadIdx.x, wid = __builtin_amdgcn_readfirstlane(tid >> 6), lane = tid & 63, wr = wid >> 2, wc = wid & 3, fr = lane & 15, fq = lane >> 4;
    const int K = g.K, nt = K / BK;
    unsigned voffA[2], voffB[2];
#pragma unroll
    for (int i = 0; i < 2; ++i) { int R, C; stage_rc(tid * 16 + i * 8192, R, C); const int Rb = Epi::PERM ? ((R & ~31) + perm32(R & 31)) : R;
        voffA[i] = (unsigned)(R * K + C) * 2u; voffB[i] = (unsigned)(Rb * K + C) * 2u; }
    const size_t kstep = (size_t)(BK * 2);
    const size_t hstep = (size_t)HALF * K * 2;
    const size_t tstep = 2 * hstep;
    const unsigned ldsw = (unsigned)wid * 1024u;
    const int aoff = lds_byte(wr * 64 + fr, fq * 8), boff = lds_byte(wc * 32 + fr, fq * 8);
#define PG8_SA(b, h) (((b) * 2 + (h)) * HTB)
#define PG8_SB(b, h) ((4 + (b) * 2 + (h)) * HTB)
#define PG8_STAGE(bufoff, gbase, voff) do { _Pragma("unroll") for (int _i = 0; _i < 2; ++_i) \
        __builtin_amdgcn_global_load_lds((const unsigned*)((const char*)(gbase) + (voff)[_i]), (PG8_LAS unsigned*)(lds + (bufoff) + ldsw + _i * 8192), 16, 0, 0); } while (0)
#define PG8_LDA(dst, b, h) do { _Pragma("unroll") for (int m = 0; m < 4; ++m) _Pragma("unroll") for (int k = 0; k < 2; ++k) dst[m][k] = *(const PG8_LAS bf16x8*)(lds + PG8_SA(b, h) + aoff + m * 2048 + k * 1024); } while (0)
#define PG8_LDB(dst, b, h) do { _Pragma("unroll") for (int n = 0; n < 2; ++n) _Pragma("unroll") for (int k = 0; k < 2; ++k) dst[n][k] = *(const PG8_LAS bf16x8*)(lds + PG8_SB(b, h) + boff + n * 2048 + k * 1024); } while (0)
#define PG8_MMA(ai, bj, At, Bt) do { __builtin_amdgcn_s_setprio(1); _Pragma("unroll") for (int m = 0; m < 4; ++m) _Pragma("unroll") for (int n = 0; n < 2; ++n) _Pragma("unroll") for (int k = 0; k < 2; ++k) \
        acc[ai][bj][m][n] = __builtin_amdgcn_mfma_f32_16x16x32_bf16(Bt[n][k], At[m][k], acc[ai][bj][m][n], 0, 0, 0); __builtin_amdgcn_s_setprio(0); } while (0)
#define PG8_WAIT_V(n) asm volatile("s_waitcnt vmcnt(" #n ")" ::: "memory")
#define PG8_WAIT_L(n) asm volatile("s_waitcnt lgkmcnt(" #n ")" ::: "memory")
#define PG8_BAR __builtin_amdgcn_s_barrier()
#define PG8_SCHED __builtin_amdgcn_sched_barrier(0)
    Unit cur, nxt; int ui = 0;
    if (!S.next(0, cur)) return;
    f32x4 acc[2][2][4][2];
#pragma unroll
    for (int a = 0; a < 2; ++a)
#pragma unroll
        for (int b = 0; b < 2; ++b)
#pragma unroll
            for (int m = 0; m < 4; ++m)
#pragma unroll
                for (int n = 0; n < 2; ++n) acc[a][b][m][n] = (f32x4){0.f, 0.f, 0.f, 0.f};
    bf16x8 At[4][2], B0[2][2], B1[2][2];
    const char* cA = (const char*)g.A + (size_t)cur.pm * tstep; const char* cB = (const char*)g.Bt + (size_t)cur.pn * tstep;
    S.a_ready(cur);
    if constexpr (SP2) {
        PG8_STAGE(PG8_SB(0, 0), cB, voffB); PG8_STAGE(PG8_SB(0, 1), cB + hstep, voffB); PG8_STAGE(PG8_SA(0, 0), cA, voffA); PG8_STAGE(PG8_SA(0, 1), cA + hstep, voffA);
        if (wr == 1) PG8_BAR;
        PG8_WAIT_V(2); PG8_BAR;
        PG8_STAGE(PG8_SB(1, 0), cB + kstep, voffB); PG8_STAGE(PG8_SA(1, 0), cA + kstep, voffA); PG8_STAGE(PG8_SB(1, 1), cB + hstep + kstep, voffB);
        PG8_WAIT_V(6); PG8_BAR;
    } else {
        PG8_STAGE(PG8_SB(0, 0), cB, voffB); PG8_STAGE(PG8_SA(0, 0), cA, voffA); PG8_STAGE(PG8_SB(0, 1), cB + hstep, voffB); PG8_STAGE(PG8_SA(0, 1), cA + hstep, voffA);
        if (wr == 1) PG8_BAR;
        PG8_WAIT_V(4); PG8_BAR;
        PG8_STAGE(PG8_SB(1, 0), cB + kstep, voffB); PG8_STAGE(PG8_SA(1, 0), cA + kstep, voffA); PG8_STAGE(PG8_SB(1, 1), cB + hstep + kstep, voffB);
        PG8_WAIT_V(6); PG8_BAR;
    }
    for (;;) {
        const bool has_next = S.next(ui + 1, nxt);
        const char* nA = has_next ? (const char*)g.A + (size_t)nxt.pm * tstep : cA; const char* nB = has_next ? (const char*)g.Bt + (size_t)nxt.pn * tstep : cB;
        for (int t = 0; t < nt; t += 2) {
            const bool last = (t == nt - 2);
            const char* a1 = cA + (size_t)(t + 1) * kstep;
            const char* a2 = last ? nA : cA + (size_t)(t + 2) * kstep; const char* b2 = last ? nB : cB + (size_t)(t + 2) * kstep;
            const char* a3 = a2 + kstep; const char* b3 = b2 + kstep;
            if (last && has_next) S.a_ready(nxt);
            if constexpr (SP2) {
            PG8_LDB(B0, 0, 0); PG8_LDB(B1, 0, 1); PG8_SCHED; PG8_LDA(At, 0, 0); PG8_STAGE(PG8_SA(1, 1), a1 + hstep, voffA);
            PG8_WAIT_V(8); PG8_WAIT_L(0); PG8_BAR; PG8_MMA(0, 0, At, B0); PG8_MMA(0, 1, At, B1); PG8_BAR; PG8_SCHED;
            PG8_LDA(At, 0, 1); PG8_STAGE(PG8_SB(0, 0), b2, voffB); PG8_STAGE(PG8_SB(0, 1), b2 + hstep, voffB); PG8_STAGE(PG8_SA(0, 0), a2, voffA);
            PG8_WAIT_V(8); PG8_WAIT_L(0); PG8_BAR; PG8_MMA(1, 0, At, B0); PG8_MMA(1, 1, At, B1); PG8_BAR; PG8_SCHED;
            PG8_LDB(B0, 1, 0); PG8_LDB(B1, 1, 1); PG8_SCHED; PG8_LDA(At, 1, 0); PG8_STAGE(PG8_SA(0, 1), a2 + hstep, voffA);
            PG8_WAIT_V(8); PG8_WAIT_L(0); PG8_BAR; PG8_MMA(0, 0, At, B0); PG8_MMA(0, 1, At, B1); PG8_BAR; PG8_SCHED;
            PG8_LDA(At, 1, 1); PG8_STAGE(PG8_SB(1, 0), b3, voffB); PG8_STAGE(PG8_SB(1, 1), b3 + hstep, voffB); PG8_STAGE(PG8_SA(1, 0), a3, voffA);
            PG8_WAIT_V(8); PG8_WAIT_L(0); PG8_BAR; PG8_MMA(1, 0, At, B0); PG8_MMA(1, 1, At, B1); PG8_BAR; PG8_SCHED;
            } else {
            PG8_LDB(B0, 0, 0); PG8_SCHED; PG8_LDA(At, 0, 0); PG8_STAGE(PG8_SA(1, 1), a1 + hstep, voffA);
            PG8_WAIT_L(8); PG8_BAR; PG8_WAIT_L(0); PG8_MMA(0, 0, At, B0); PG8_BAR; PG8_SCHED;
            PG8_LDB(B1, 0, 1); PG8_STAGE(PG8_SB(0, 0), b2, voffB);
            PG8_BAR; PG8_WAIT_L(0); PG8_MMA(0, 1, At, B1); PG8_BAR;
            PG8_LDA(At, 0, 1); PG8_STAGE(PG8_SA(0, 0), a2, voffA);
            PG8_BAR; PG8_WAIT_L(0); PG8_MMA(1, 0, At, B0); PG8_BAR; PG8_SCHED;
            PG8_STAGE(PG8_SB(0, 1), b2 + hstep, voffB);
            PG8_WAIT_V(6); PG8_BAR; PG8_MMA(1, 1, At, B1); PG8_BAR;
            PG8_LDB(B0, 1, 0); PG8_SCHED; PG8_LDA(At, 1, 0); PG8_STAGE(PG8_SA(0, 1), a2 + hstep, voffA);
            PG8_WAIT_L(8); PG8_BAR; PG8_WAIT_L(0); PG8_MMA(0, 0, At, B0); PG8_BAR; PG8_SCHED;
            PG8_LDB(B1, 1, 1); PG8_STAGE(PG8_SB(1, 0), b3, voffB);
            PG8_BAR; PG8_WAIT_L(0); PG8_MMA(0, 1, At, B1); PG8_BAR;
            PG8_LDA(At, 1, 1); PG8_STAGE(PG8_SA(1, 0), a3, voffA);
            PG8_BAR; PG8_WAIT_L(0); PG8_MMA(1, 0, At, B0); PG8_BAR; PG8_SCHED;
            PG8_STAGE(PG8_SB(1, 1), b3 + hstep, voffB);
            PG8_WAIT_V(6); PG8_BAR; PG8_MMA(1, 1, At, B1); PG8_BAR;
            }
        }
        if constexpr (ALIGN_EPI) { if (wr == 0) PG8_BAR; }
        if constexpr (!Epi::AFTER_DRAIN) { E(acc, cur, wr, wc, fr, fq); S.done(cur); }
        if (!has_next) break;
#pragma unroll
        for (int a = 0; a < 2; ++a)
#pragma unroll
            for (int b = 0; b < 2; ++b)
#pragma unroll
                for (int m = 0; m < 4; ++m)
#pragma unroll
                    for (int n = 0; n < 2; ++n) acc[a][b][m][n] = (f32x4){0.f, 0.f, 0.f, 0.f};
        cur = nxt; cA = nA; cB = nB; ++ui;
        if constexpr (ALIGN_EPI) { if (wr == 1) PG8_BAR; }
    }
    PG8_WAIT_V(0);
    if constexpr (!ALIGN_EPI) { if (wr == 0) PG8_BAR; }
    PG8_BAR;
    if constexpr (Epi::AFTER_DRAIN) { E.fused(acc, cur, wr, wc, fr, fq, lds, wid, lane); S.done(cur); }
#undef PG8_SA
#undef PG8_SB
#undef PG8_STAGE
#undef PG8_LDA
#undef PG8_LDB
#undef PG8_MMA
#undef PG8_WAIT_V
#undef PG8_WAIT_L
#undef PG8_BAR
#undef PG8_SCHED
}
}
#define LAS __attribute__((address_space(3)))
#define XB_TMO      128
#define XB_XCNT(j)  (256  + 64 * (j))
#define XB_XSUB(j)  (1280 + 64 * (j))
#define XB_XGEN(j)  (2304 + 64 * (j))
#define XB_TOP      3328
#define XB_TOPGEN   3392
#define XCD_BAR_WORDS 3456
#define XB_SPIN_CAP (1u << 18)

__device__ __forceinline__ unsigned xb_ld(unsigned* p)              { return __hip_atomic_load(p, __ATOMIC_RELAXED, __HIP_MEMORY_SCOPE_AGENT); }
__device__ __forceinline__ unsigned xb_add(unsigned* p, unsigned v) { return __hip_atomic_fetch_add(p, v, __ATOMIC_RELAXED, __HIP_MEMORY_SCOPE_AGENT); }
__device__ __forceinline__ unsigned xb_xcc_id() { return (unsigned)__builtin_amdgcn_s_getreg((3 << 11) | 20) & 0xFu; }
#define XB_SPIN(cond, bar) do { unsigned _sp = 0; while (cond) { __builtin_amdgcn_s_sleep(1); \
    if ((++_sp & 255u) == 0u) { if (xb_ld(&(bar)[XB_TMO])) break; if (_sp > XB_SPIN_CAP) { atomicAdd(&(bar)[XB_TMO], 1u); break; } } } } while (0)

struct XcdBarrier {
    unsigned* bar; unsigned x;
    volatile LAS unsigned* st;
};

__device__ __forceinline__ XcdBarrier xcd_barrier_post(unsigned* bar, volatile LAS unsigned* st) {
    XcdBarrier b; b.bar = bar; b.x = xb_xcc_id(); b.st = st;
    if (threadIdx.x == 0) (void)xb_add(&bar[XB_XCNT(b.x)], 1u);
    return b;
}
__device__ __forceinline__ void xcd_barrier_complete(unsigned* bar, unsigned x, unsigned& nloc, unsigned& nx) {
    const unsigned G = gridDim.x * gridDim.y * gridDim.z;
    unsigned sum, cnt, mine, sp = 0u;
    for (;;) {
        sum = 0u; cnt = 0u; mine = 0u;
#pragma unroll
        for (unsigned j = 0; j < 16; ++j) { const unsigned c = xb_ld(&bar[XB_XCNT(j)]); sum += c; cnt += (c > 0u) ? 1u : 0u; mine = (j == x) ? c : mine; }
        if (sum == G) break;
        __builtin_amdgcn_s_sleep(1);
        if ((++sp & 255u) == 0u) { if (xb_ld(&bar[XB_TMO])) break; if (sp > XB_SPIN_CAP) { atomicAdd(&bar[XB_TMO], 1u); break; } }
    }
    nloc = mine > 0u ? mine : 1u; nx = cnt > 0u ? cnt : 1u;
}

__device__ __forceinline__ void xcd_barrier(const XcdBarrier& b) {
    asm volatile("s_waitcnt vmcnt(0)" ::: "memory");
    __syncthreads();
    if (threadIdx.x == 0) {
        unsigned* bar = b.bar;
        __builtin_amdgcn_s_waitcnt(0);
        unsigned nloc = b.st[0], nx = b.st[1];
        if (nloc == 0u) { xcd_barrier_complete(bar, b.x, nloc, nx); b.st[0] = nloc; b.st[1] = nx; }
        const unsigned old = xb_add(&bar[XB_XSUB(b.x)], 1u);
        const unsigned gen = old / nloc;
        if (old + 1u == (gen + 1u) * nloc) {
            __builtin_amdgcn_fence(__ATOMIC_RELEASE, "agent");
            asm volatile("s_waitcnt vmcnt(0)" ::: "memory");
            const unsigned og = xb_add(&bar[XB_TOP], 1u);
            const unsigned tg = og / nx;
            if (og + 1u == (tg + 1u) * nx) xb_add(&bar[XB_TOPGEN], 1u);
            else XB_SPIN(xb_ld(&bar[XB_TOPGEN]) == tg, bar);
            __builtin_amdgcn_fence(__ATOMIC_ACQUIRE, "agent");
            xb_add(&bar[XB_XGEN(b.x)], 1u);
            asm volatile("s_waitcnt vmcnt(0)" ::: "memory");
        } else {
            XB_SPIN(xb_ld(&bar[XB_XGEN(b.x)]) == gen, bar);
            __builtin_amdgcn_fence(__ATOMIC_ACQUIRE, "agent");
            asm volatile("s_waitcnt vmcnt(0)" ::: "memory");
        }
    }
    __syncthreads();
}

constexpr int NB = 8, SEQ = 2048, DMODEL = 1024, NTOK = NB * SEQ, NMEM = 256, NMEMTOK = NB * NMEM;
constexpr int NPROJ = 3784, NPAD = 3840;
constexpr int C_QA = 0, C_KA = 512, C_VA = 1024, C_QB = 1536, C_KB = 1792, C_VB = 1856, C_QM = 1920, C_GATE = 2176, C_QI = 3200, C_KI = 3712, C_WI = 3776;
constexpr float RMS_EPS = 1e-6f;
constexpr float LOG2E = 1.4426950408889634f;
constexpr float C2 = 0.125f * LOG2E;

constexpr size_t MiB = 1u << 20;
constexpr size_t WS_SS = 0;
constexpr size_t WS_BAR = 1 * MiB, BAR_BYTES = 16384;
constexpr size_t WS_WT = 2 * MiB;
constexpr size_t WS_WOUT = 11 * MiB;
constexpr size_t WS_XN = 16 * MiB;
constexpr size_t WS_OG = 16 * MiB;
constexpr size_t WS_PROJ = 52 * MiB;
constexpr size_t WS_KVM = 172 * MiB;
constexpr size_t WS_MASK = 174 * MiB;
constexpr size_t WS_LSE = 178 * MiB;
constexpr size_t WS_OAP = 180 * MiB;
constexpr size_t WS_END = 228 * MiB;

constexpr int LDS_BYTES = 143360;
constexpr int NWAVES = 8;
constexpr int MISC_OFF = LDS_BYTES - 64;

typedef unsigned short bf16;
typedef short bf16x8 __attribute__((ext_vector_type(8)));
typedef short s16x4 __attribute__((ext_vector_type(4)));
typedef float f32x4 __attribute__((ext_vector_type(4)));
typedef float f32x16 __attribute__((ext_vector_type(16)));
typedef unsigned u32x4 __attribute__((ext_vector_type(4)));
typedef unsigned u32x2 __attribute__((ext_vector_type(2)));
#define LAS __attribute__((address_space(3)))

__device__ __forceinline__ float bf2f(unsigned short b) { return __uint_as_float(((unsigned)b) << 16); }
__device__ __forceinline__ float bflo(unsigned w) { return __uint_as_float(w << 16); }
__device__ __forceinline__ float bfhi(unsigned w) { return __uint_as_float(w & 0xffff0000u); }
typedef float f32x2_t __attribute__((ext_vector_type(2))); typedef __bf16 bf16x2_t __attribute__((ext_vector_type(2)));
__device__ __forceinline__ unsigned cvtpk(float lo, float hi) { f32x2_t v = {lo, hi}; bf16x2_t b = __builtin_convertvector(v, bf16x2_t); return __builtin_bit_cast(unsigned, b); }
__device__ __forceinline__ float wave_sum(float v) {
#pragma unroll
    for (int o = 1; o < 64; o <<= 1) v += __shfl_xor(v, o);
    return v;
}
__device__ __forceinline__ float silu(float g) { return g * __builtin_amdgcn_rcpf(1.0f + __builtin_amdgcn_exp2f(-g * LOG2E)); }

struct Args { const float* x; const float* mem; const float* g_in; const float* g_mem; const float* w_in; const float* w_mem; const float* w_out; const float* g_final;
              float* out; unsigned char* ws; int ph_lo, ph_hi; };

__device__ __forceinline__ void p0_transpose_item(const float* W, int K, int N, int nblk, bf16* WT, int row_off, LAS float* scr, int item, int lane) {
    const int kb = item / nblk, nb = item % nblk, k0 = 64 * kb, n0 = 32 * nb;
    const int n_in = n0 + (lane & 31);
#pragma unroll 8
    for (int i = 0; i < 32; ++i) { const int kk = 2 * i + (lane >> 5); scr[kk * 33 + (lane & 31)] = (n_in < N) ? W[(size_t)(k0 + kk) * N + n_in] : 0.f; }
    asm volatile("s_waitcnt lgkmcnt(0)" ::: "memory");
    const int c = lane & 7;
#pragma unroll
    for (int j = 0; j < 4; ++j) { const int n = (lane >> 3) + 8 * j; const LAS float* s = scr + (8 * c) * 33 + n;
        u32x4 o; o.x = cvtpk(s[0 * 33], s[1 * 33]); o.y = cvtpk(s[2 * 33], s[3 * 33]); o.z = cvtpk(s[4 * 33], s[5 * 33]); o.w = cvtpk(s[6 * 33], s[7 * 33]);
        *(u32x4*)(WT + (size_t)(row_off + n0 + n) * K + k0 + 8 * c) = o; }
    asm volatile("s_waitcnt lgkmcnt(0)" ::: "memory");
}
__device__ __forceinline__ void rms_row_to_bf16(const float* xrow, const f32x4 (&g)[4], bf16* orow, int lane) {
    const f32x4* xr = (const f32x4*)xrow + lane;
    f32x4 v[4]; float s = 0.f;
#pragma unroll
    for (int j = 0; j < 4; ++j) { v[j] = xr[64 * j]; s += (v[j].x * v[j].x + v[j].y * v[j].y) + (v[j].z * v[j].z + v[j].w * v[j].w); }
    const float r = 1.0f / sqrtf(wave_sum(s) * (1.f / DMODEL) + RMS_EPS);
    u32x2* o8 = (u32x2*)orow + lane;
#pragma unroll
    for (int j = 0; j < 4; ++j) { const f32x4 h = v[j] * r * g[j]; u32x2 w; w.x = cvtpk(h.x, h.y); w.y = cvtpk(h.z, h.w); o8[64 * j] = w; }
}
__device__ __forceinline__ void p0_prologue(const Args& a, LAS unsigned char* lds, int wave, int lane) {
    LAS float* scr = (LAS float*)(lds + wave * 8448);
    const int gw = blockIdx.x * NWAVES + wave, NGW = gridDim.x * NWAVES;
    bf16* WT = (bf16*)(a.ws + WS_WT); bf16* WOUT = (bf16*)(a.ws + WS_WOUT); bf16* XN = (bf16*)(a.ws + WS_XN); float* SS = (float*)(a.ws + WS_SS);
    constexpr int I_IN = 16 * 120, I_MEM = 16 * 16, I_OUT = 16 * 32;
    for (int it = gw; it < I_IN + I_MEM + I_OUT; it += NGW) {
        int r = it;
        if (r < I_IN) { p0_transpose_item(a.w_in, 1024, NPROJ, 120, WT, 0, scr, r, lane); continue; } r -= I_IN;
        if (r < I_MEM) { p0_transpose_item(a.w_mem, 1024, 512, 16, WT, NPAD, scr, r, lane); continue; } r -= I_MEM;
        p0_transpose_item(a.w_out, 1024, 1024, 32, WOUT, 0, scr, r, lane);
    }
    { f32x4 g[4];
#pragma unroll
      for (int j = 0; j < 4; ++j) g[j] = ((const f32x4*)a.g_in)[lane + 64 * j];
      for (int m = gw; m < NTOK; m += NGW) rms_row_to_bf16(a.x + (size_t)m * DMODEL, g, XN + (size_t)m * DMODEL, lane);
#pragma unroll
      for (int j = 0; j < 4; ++j) g[j] = ((const f32x4*)a.g_mem)[lane + 64 * j];
      for (int m = gw; m < NMEMTOK; m += NGW) rms_row_to_bf16(a.mem + (size_t)m * DMODEL, g, XN + (size_t)(NTOK + m) * DMODEL, lane); }
    for (int i = blockIdx.x * 512 + threadIdx.x; i < NTOK; i += gridDim.x * 512) SS[i] = 0.f;
}

__device__ __forceinline__ int crow(int r, int hi) { return (r & 3) + 8 * (r >> 2) + 4 * hi; }
#define MFMA32(a, b, c) __builtin_amdgcn_mfma_f32_32x32x16_bf16(a, b, c, 0, 0, 0)
typedef short v4i16_t __attribute__((ext_vector_type(4)));
__device__ __forceinline__ s16x4 vtr(LAS const unsigned char* p) { return __builtin_bit_cast(s16x4, __builtin_amdgcn_ds_read_tr16_b64_v4i16((LAS v4i16_t*)p)); }

__device__ __forceinline__ void att_load_tile(LAS unsigned char* Ks, LAS unsigned char* Vs, const bf16* Kg, const bf16* Vg, long rstride, int key0, int nkeys, int wid, int lane) {
    { const int key = key0 + lane; u32x4 v = {0u, 0u, 0u, 0u}; if (key >= 0 && key < nkeys) v = *(const u32x4*)(Kg + (long)key * rstride + wid * 8); *(LAS u32x4*)(Ks + wid * 1024 + lane * 16) = v; }
    { const int key = key0 + 16 * (wid & 3) + (lane >> 2); u32x4 v = {0u, 0u, 0u, 0u}; if (key >= 0 && key < nkeys) v = *(const u32x4*)(Vg + (long)key * rstride + (wid >> 2) * 32 + (lane & 3) * 8);
      *(LAS u32x4*)(Vs + wid * 1024 + lane * 16) = v; }
}
__device__ __forceinline__ void att_qkt(f32x16& p0, f32x16& p1, LAS const unsigned char* Ks, const bf16x8 (&qr)[4], int r32, int hi) {
    LAS const unsigned char* kb = Ks + hi * 1024 + r32 * 16;
    const f32x16 z = {0.f, 0.f, 0.f, 0.f, 0.f, 0.f, 0.f, 0.f, 0.f, 0.f, 0.f, 0.f, 0.f, 0.f, 0.f, 0.f};
    p0 = z; p1 = z;
#pragma unroll
    for (int d0 = 0; d0 < 4; ++d0) {
        const bf16x8 b0 = *(LAS const bf16x8*)(kb + d0 * 2048), b1 = *(LAS const bf16x8*)(kb + d0 * 2048 + 512);
        p0 = MFMA32(b0, qr[d0], p0); p1 = MFMA32(b1, qr[d0], p1); }
}
__device__ __forceinline__ float att_rowmax(const f32x16& p0, const f32x16& p1) {
    float a = fmaxf(p0[0], p1[0]);
#pragma unroll
    for (int r = 1; r < 16; ++r) a = fmaxf(a, fmaxf(p0[r], p1[r]));
    auto rr = __builtin_amdgcn_permlane32_swap(__float_as_uint(a), __float_as_uint(a), false, false);
    return fmaxf(__uint_as_float(rr[0]), __uint_as_float(rr[1]));
}
struct AttState { float m, l; f32x16 o[2]; };
__device__ __forceinline__ void att_init(AttState& s) { s.m = -1e30f; s.l = 0.f;
#pragma unroll
    for (int r = 0; r < 16; ++r) { s.o[0][r] = 0.f; s.o[1][r] = 0.f; } }
__device__ __forceinline__ void att_update(AttState& s, f32x16& p0, f32x16& p1, LAS float* wsf, LAS const unsigned char* Vs, int lane, int r32, int hi) {
    const float rm = att_rowmax(p0, p1);
    const float mn = fmaxf(s.m, rm); const float alpha = __builtin_amdgcn_exp2f(s.m - mn); s.m = mn;
    float sum = 0.f;
#pragma unroll
    for (int r = 0; r < 16; ++r) { p0[r] = __builtin_amdgcn_exp2f(p0[r] - mn); p1[r] = __builtin_amdgcn_exp2f(p1[r] - mn); sum += p0[r] + p1[r]; }
    s.l = s.l * alpha + sum;
    if (hi == 0) wsf[r32] = alpha;
    asm volatile("s_waitcnt lgkmcnt(0)" ::: "memory");
#pragma unroll
    for (int r = 0; r < 16; ++r) { const float f = wsf[crow(r, hi)]; s.o[0][r] *= f; s.o[1][r] *= f; }
    u32x4 pw[4];
#pragma unroll
    for (int k = 0; k < 2; ++k) {
        pw[k]     = (u32x4){cvtpk(p0[8 * k + 0], p0[8 * k + 1]), cvtpk(p0[8 * k + 2], p0[8 * k + 3]), cvtpk(p0[8 * k + 4], p0[8 * k + 5]), cvtpk(p0[8 * k + 6], p0[8 * k + 7])};
        pw[2 + k] = (u32x4){cvtpk(p1[8 * k + 0], p1[8 * k + 1]), cvtpk(p1[8 * k + 2], p1[8 * k + 3]), cvtpk(p1[8 * k + 4], p1[8 * k + 5]), cvtpk(p1[8 * k + 6], p1[8 * k + 7])}; }
    LAS const unsigned char* vp = Vs + ((lane >> 4) & 1) * 32 + (lane & 3) * 8 + (4 * hi + ((lane & 15) >> 2)) * 64;
#pragma unroll
    for (int dh = 0; dh < 2; ++dh)
#pragma unroll
        for (int ks = 0; ks < 4; ++ks) {
            const s16x4 lo = vtr(vp + dh * 4096 + ks * 1024), hh = vtr(vp + dh * 4096 + ks * 1024 + 512);
            const bf16x8 vf = (bf16x8){lo[0], lo[1], lo[2], lo[3], hh[0], hh[1], hh[2], hh[3]};
            s.o[dh] = MFMA32(__builtin_bit_cast(bf16x8, pw[ks]), vf, s.o[dh]); }
}
__device__ __forceinline__ float att_finish(AttState& s, float (&rli)[16], LAS float* wsf, int r32, int hi) {
    auto rr = __builtin_amdgcn_permlane32_swap(__float_as_uint(s.l), __float_as_uint(s.l), false, false);
    const float l = __uint_as_float(rr[0]) + __uint_as_float(rr[1]);
    if (hi == 0) wsf[32 + r32] = l;
    asm volatile("s_waitcnt lgkmcnt(0)" ::: "memory");
#pragma unroll
    for (int r = 0; r < 16; ++r) rli[r] = __builtin_amdgcn_rcpf(wsf[32 + crow(r, hi)]);
    return l;
}

constexpr int ATT_K = 0, ATT_V = 8192, ATT_WS = 16384;

__device__ __forceinline__ void attA_unit(const Args& a, LAS unsigned char* lds, int u, int wid, int lane) {
    const int r32 = lane & 31, hi = lane >> 5;
    int p, d, b, h, res, i0, n;
    if (u < 512) { p = 0; d = 1; n = 2048; b = u >> 6; h = (u >> 3) & 7; res = 0; i0 = (u & 7) * 256; }
    else if (u < 1024) { const int v = u - 512; p = 1; d = 4; n = 512; b = v >> 6; h = (v >> 3) & 7; res = (v >> 1) & 3; i0 = (v & 1) * 256; }
    else { const int v = u - 1024; p = 2; d = 16; n = 128; b = v >> 7; h = (v >> 4) & 7; res = v & 15; i0 = 0; }
    const bf16* PROJ = (const bf16*)(a.ws + WS_PROJ);
    const bf16* base = PROJ + (size_t)(b * SEQ + res) * NPAD + h * 64;
    const long rstride = (long)d * NPAD;
    const bf16* Kg = base + C_KA; const bf16* Vg = base + C_VA;
    const int qa = i0 + 32 * wid; const bool active = qa < n;
    const int qi = qa + r32;
    bf16x8 qr[4];
    if (active) {
#pragma unroll
        for (int d0 = 0; d0 < 4; ++d0) qr[d0] = *(const bf16x8*)(base + (long)qi * rstride + C_QA + d0 * 16 + hi * 8);
    } else {
#pragma unroll
        for (int d0 = 0; d0 < 4; ++d0) qr[d0] = (bf16x8){0, 0, 0, 0, 0, 0, 0, 0};
    }
    AttState st; att_init(st);
    LAS float* wsf = (LAS float*)(lds + ATT_WS) + wid * 64;
    const float nb2 = -exp2f(-(float)(h + 1)) * (float)d * LOG2E;
    const int kt_lo = (i0 >= 128) ? (i0 - 128) / 64 : 0; int kt_hi = (i0 + 255) / 64; if (kt_hi > n / 64 - 1) kt_hi = n / 64 - 1;
    for (int kt = kt_lo; kt <= kt_hi; ++kt) {
        __syncthreads();
        att_load_tile(lds + ATT_K, lds + ATT_V, Kg, Vg, rstride, kt * 64, n, wid, lane);
        __syncthreads();
        const bool need = active && (64 * kt <= qa + 31) && (64 * kt + 63 >= qa - 128);
        if (need) {
            f32x16 p0, p1; att_qkt(p0, p1, lds + ATT_K, qr, r32, hi);
            const int qk0 = qi - 64 * kt;
#pragma unroll
            for (int r = 0; r < 16; ++r) { const int d0 = qk0 - crow(r, hi), d1 = d0 - 32;
                p0[r] = ((unsigned)d0 <= 128u) ? p0[r] * C2 + nb2 * (float)d0 : -INFINITY;
                p1[r] = ((unsigned)d1 <= 128u) ? p1[r] * C2 + nb2 * (float)d1 : -INFINITY; }
            att_update(st, p0, p1, wsf, lds + ATT_V, lane, r32, hi);
        }
    }
    if (active) {
        float rli[16]; const float l = att_finish(st, rli, wsf, r32, hi);
        bf16* OAP = (bf16*)(a.ws + WS_OAP) + (size_t)p * NTOK * 512; float* LSE = (float*)(a.ws + WS_LSE) + (size_t)p * NTOK * 8;
        if (hi == 0) LSE[(size_t)(b * SEQ + res + d * qi) * 8 + h] = st.m + __builtin_amdgcn_logf(l);
#pragma unroll
        for (int r = 0; r < 16; ++r) { const int q = qa + crow(r, hi); bf16* orow = OAP + (size_t)(b * SEQ + res + d * q) * 512 + h * 64 + r32;
            orow[0] = (bf16)(cvtpk(st.o[0][r] * rli[r], 0.f) & 0xffffu); orow[32] = (bf16)(cvtpk(st.o[1][r] * rli[r], 0.f) & 0xffffu); }
    }
}

__device__ __forceinline__ void attM_unit(const Args& a, LAS unsigned char* lds, int u, int wid, int lane) {
    const int r32 = lane & 31, hi = lane >> 5;
    const int b = u >> 5, h = (u >> 3) & 3, q0 = (u & 7) * 256;
    const bf16* PROJ = (const bf16*)(a.ws + WS_PROJ); const bf16* KVM = (const bf16*)(a.ws + WS_KVM);
    const bf16* Kg = KVM + (size_t)(b * NMEM) * 512 + h * 64; const bf16* Vg = Kg + 256;
    const int qi = q0 + 32 * wid + r32;
    bf16x8 qr[4];
#pragma unroll
    for (int d0 = 0; d0 < 4; ++d0) qr[d0] = *(const bf16x8*)(PROJ + (size_t)(b * SEQ + qi) * NPAD + C_QM + h * 64 + d0 * 16 + hi * 8);
    AttState st; att_init(st);
    LAS float* wsf = (LAS float*)(lds + ATT_WS) + wid * 64;
    for (int kt = 0; kt < 4; ++kt) {
        __syncthreads();
        att_load_tile(lds + ATT_K, lds + ATT_V, Kg, Vg, 512, kt * 64, NMEM, wid, lane);
        __syncthreads();
        f32x16 p0, p1; att_qkt(p0, p1, lds + ATT_K, qr, r32, hi);
#pragma unroll
        for (int r = 0; r < 16; ++r) { p0[r] *= C2; p1[r] *= C2; }
        att_update(st, p0, p1, wsf, lds + ATT_V, lane, r32, hi);
    }
    float rli[16]; att_finish(st, rli, wsf, r32, hi);
    bf16* OG = (bf16*)(a.ws + WS_OG);
#pragma unroll
    for (int r = 0; r < 16; ++r) { const int q = q0 + 32 * wid + crow(r, hi); const size_t row = (size_t)(b * SEQ + q);
        const bf16* grow = PROJ + row * NPAD + C_GATE + 768 + h * 64 + r32; bf16* orow = OG + row * 1024 + 768 + h * 64 + r32;
        orow[0] = (bf16)(cvtpk(st.o[0][r] * rli[r] * silu(bf2f(grow[0])), 0.f) & 0xffffu); orow[32] = (bf16)(cvtpk(st.o[1][r] * rli[r] * silu(bf2f(grow[32])), 0.f) & 0xffffu); }
}

__device__ __forceinline__ void attB_unit(const Args& a, LAS unsigned char* lds, int u, int wid, int lane) {
    const int r32 = lane & 31, hi = lane >> 5;
    const int b = u >> 5, qb = u & 31, h = wid & 3;
    const bf16* PROJ = (const bf16*)(a.ws + WS_PROJ);
    const bf16* base = PROJ + (size_t)(b * SEQ) * NPAD;
    const bf16* Kg = base + C_KB; const bf16* Vg = base + C_VB;
    const int qa = qb * 64 + 32 * (wid >> 2); const int t = qa + r32;
    bf16x8 qr[4];
#pragma unroll
    for (int d0 = 0; d0 < 4; ++d0) qr[d0] = *(const bf16x8*)(base + (size_t)t * NPAD + C_QB + h * 64 + d0 * 16 + hi * 8);
    const unsigned long long* MASK = (const unsigned long long*)(a.ws + WS_MASK) + (size_t)(b * SEQ + t) * 32;
    AttState st; att_init(st);
    LAS float* wsf = (LAS float*)(lds + ATT_WS) + wid * 64;
    const float nb2 = -exp2f(-2.0f * (float)(h + 1)) * LOG2E;
    for (int kt = 0; kt <= qb; ++kt) {
        __syncthreads();
        att_load_tile(lds + ATT_K, lds + ATT_V, Kg, Vg, NPAD, kt * 64, SEQ, wid, lane);
        const unsigned long long bits = MASK[kt];
        __syncthreads();
        f32x16 p0, p1; att_qkt(p0, p1, lds + ATT_K, qr, r32, hi);
        const int qk0 = t - 64 * kt; const unsigned blo = (unsigned)bits, bhi = (unsigned)(bits >> 32);
#pragma unroll
        for (int r = 0; r < 16; ++r) { const int kv = crow(r, hi); const int d0 = qk0 - kv, d1 = d0 - 32;
            p0[r] = ((blo >> kv) & 1u) ? p0[r] * C2 + nb2 * (float)d0 : -INFINITY;
            p1[r] = ((bhi >> kv) & 1u) ? p1[r] * C2 + nb2 * (float)d1 : -INFINITY; }
        att_update(st, p0, p1, wsf, lds + ATT_V, lane, r32, hi);
    }
    float rli[16]; att_finish(st, rli, wsf, r32, hi);
    bf16* OG = (bf16*)(a.ws + WS_OG);
#pragma unroll
    for (int r = 0; r < 16; ++r) { const int q = qa + crow(r, hi); const size_t row = (size_t)(b * SEQ + q);
        const bf16* grow = PROJ + row * NPAD + C_GATE + 512 + h * 64 + r32; bf16* orow = OG + row * 1024 + 512 + h * 64 + r32;
        orow[0] = (bf16)(cvtpk(st.o[0][r] * rli[r] * silu(bf2f(grow[0])), 0.f) & 0xffffu); orow[32] = (bf16)(cvtpk(st.o[1][r] * rli[r] * silu(bf2f(grow[32])), 0.f) & 0xffffu); }
}

constexpr int IDX_PITCH = 2052;
__device__ __forceinline__ void idx_unit(const Args& a, LAS unsigned char* lds, int u, int wid, int lane) {
    const int b = u >> 7, t0 = (u & 127) * 16; const int fr = lane & 15, fq = lane >> 4;
    LAS float* SC = (LAS float*)lds;
    const bf16* PROJ = (const bf16*)(a.ws + WS_PROJ);
    const bf16* qrow = PROJ + (size_t)(b * SEQ + t0 + fr) * NPAD;
    bf16x8 qf[8][2];
#pragma unroll
    for (int h = 0; h < 8; ++h)
#pragma unroll
        for (int ks = 0; ks < 2; ++ks) qf[h][ks] = *(const bf16x8*)(qrow + C_QI + h * 64 + ks * 32 + fq * 8);
    float wv[8];
    { const u32x4 w = *(const u32x4*)(qrow + C_WI); wv[0] = bflo(w.x); wv[1] = bfhi(w.x); wv[2] = bflo(w.y); wv[3] = bfhi(w.y); wv[4] = bflo(w.z); wv[5] = bfhi(w.z); wv[6] = bflo(w.w); wv[7] = bfhi(w.w); }
    const int ntiles = t0 / 16 + 1;
    __syncthreads();
    for (int kt = wid; kt < ntiles; kt += 8) {
        const bf16* krow = PROJ + (size_t)(b * SEQ + kt * 16 + fr) * NPAD + C_KI + fq * 8;
        const bf16x8 k0 = *(const bf16x8*)krow, k1 = *(const bf16x8*)(krow + 32);
        f32x4 sc = {0.f, 0.f, 0.f, 0.f};
#pragma unroll
        for (int h = 0; h < 8; ++h) { f32x4 acc = {0.f, 0.f, 0.f, 0.f};
            acc = __builtin_amdgcn_mfma_f32_16x16x32_bf16(k0, qf[h][0], acc, 0, 0, 0); acc = __builtin_amdgcn_mfma_f32_16x16x32_bf16(k1, qf[h][1], acc, 0, 0, 0);
#pragma unroll
            for (int i = 0; i < 4; ++i) sc[i] += wv[h] * fmaxf(acc[i], 0.f); }
        *(LAS f32x4*)(SC + fr * IDX_PITCH + kt * 16 + fq * 4) = sc;
    }
    __syncthreads();
    unsigned long long* MASK = (unsigned long long*)(a.ws + WS_MASK);
#pragma unroll 1
    for (int rr = 2 * wid; rr < 2 * wid + 2; ++rr) {
        const int t = t0 + rr;
        unsigned uu[32];
#pragma unroll
        for (int j = 0; j < 32; ++j) { const int key = 64 * j + lane; const unsigned bits = __float_as_uint(SC[rr * IDX_PITCH + key]);
            const unsigned s = bits ^ ((bits & 0x80000000u) ? 0xffffffffu : 0x80000000u); uu[j] = (key <= t) ? s : 0u; }
        unsigned tau = 1u;
        if (t >= 256) {
            tau = 0u;
#pragma unroll 1
            for (int bit = 31; bit >= 0; --bit) {
                const unsigned cand = tau | (1u << bit); int c = 0;
#pragma unroll
                for (int j = 0; j < 32; ++j) c += __builtin_popcountll(__ballot(uu[j] >= cand));
                if (c >= 256) tau = cand;
                if (c == 256) break;
            }
        }
        int cgt = 0;
#pragma unroll
        for (int j = 0; j < 32; ++j) cgt += __builtin_popcountll(__ballot(uu[j] > tau));
        const int need = 256 - cgt;
        int base = 0; unsigned long long mine = 0ull;
        const unsigned long long lt = (1ull << lane) - 1ull;
#pragma unroll
        for (int j = 0; j < 32; ++j) {
            const bool eq = (uu[j] == tau) && (uu[j] != 0u); const unsigned long long be = __ballot(eq);
            const int rank = base + __builtin_popcountll(be & lt);
            const bool sel = (uu[j] > tau) || (eq && rank < need);
            const unsigned long long bm = __ballot(sel);
            base += __builtin_popcountll(be);
            if (lane == j) mine = bm;
        }
        if (lane < 32) MASK[(size_t)(b * SEQ + t) * 32 + lane] = mine;
    }
}

__device__ __forceinline__ void merge_rows(const Args& a, int wave, int lane) {
    const int gw = blockIdx.x * NWAVES + wave, NGW = gridDim.x * NWAVES;
    const bf16* PROJ = (const bf16*)(a.ws + WS_PROJ); const bf16* OAP = (const bf16*)(a.ws + WS_OAP); const float* LSE = (const float*)(a.ws + WS_LSE); bf16* OG = (bf16*)(a.ws + WS_OG);
    const int h = lane >> 3, dof = (lane & 7) * 8;
    for (int tok = gw; tok < NTOK; tok += NGW) {
        const float l0 = LSE[(size_t)tok * 8 + h], l1 = LSE[(size_t)(NTOK + tok) * 8 + h], l2 = LSE[(size_t)(2 * NTOK + tok) * 8 + h];
        const float mx = fmaxf(l0, fmaxf(l1, l2));
        float w0 = __builtin_amdgcn_exp2f(l0 - mx), w1 = __builtin_amdgcn_exp2f(l1 - mx), w2 = __builtin_amdgcn_exp2f(l2 - mx);
        const float inv = 1.0f / (w0 + w1 + w2); w0 *= inv; w1 *= inv; w2 *= inv;
        const u32x4 o0 = *(const u32x4*)(OAP + (size_t)tok * 512 + h * 64 + dof), o1 = *(const u32x4*)(OAP + (size_t)(NTOK + tok) * 512 + h * 64 + dof), o2 = *(const u32x4*)(OAP + (size_t)(2 * NTOK + tok) * 512 + h * 64 + dof);
        const u32x4 g = *(const u32x4*)(PROJ + (size_t)tok * NPAD + C_GATE + h * 64 + dof);
        u32x4 res;
#pragma unroll
        for (int i = 0; i < 4; ++i) {
            const float lo = (w0 * bflo(o0[i]) + w1 * bflo(o1[i]) + w2 * bflo(o2[i])) * silu(bflo(g[i]));
            const float hi = (w0 * bfhi(o0[i]) + w1 * bfhi(o1[i]) + w2 * bfhi(o2[i])) * silu(bfhi(g[i]));
            res[i] = cvtpk(lo, hi); }
        *(u32x4*)(OG + (size_t)tok * 1024 + h * 64 + dof) = res;
    }
}

__device__ __forceinline__ void final_norm(const Args& a, int wave, int lane) {
    const int gw = blockIdx.x * NWAVES + wave, NGW = gridDim.x * NWAVES;
    const float* SS = (const float*)(a.ws + WS_SS);
    f32x4 g[4];
#pragma unroll
    for (int j = 0; j < 4; ++j) g[j] = ((const f32x4*)a.g_final)[lane + 64 * j];
    for (int m = gw; m < NTOK; m += NGW) {
        const float r = 1.0f / sqrtf(SS[m] * (1.f / DMODEL) + RMS_EPS);
        f32x4* row = (f32x4*)(a.out + (size_t)m * DMODEL) + lane;
#pragma unroll
        for (int j = 0; j < 4; ++j) row[64 * j] = row[64 * j] * r * g[j];
    }
}

__global__ void __launch_bounds__(NWAVES * 64, 2) fwd_kernel(Args a) {
    extern __shared__ __attribute__((aligned(16))) unsigned char smem[];
    LAS unsigned char* lds = (LAS unsigned char*)smem;
    const int tid = threadIdx.x, lane = tid & 63, wave = __builtin_amdgcn_readfirstlane(tid >> 6);
    if (tid < 16) ((LAS unsigned*)(lds + MISC_OFF))[tid] = 0u;
    __syncthreads();
    XcdBarrier bar = xcd_barrier_post((unsigned*)(a.ws + WS_BAR), (volatile LAS unsigned*)(lds + MISC_OFF));
    if (a.ph_lo < 0) { cg::grid_group grid = cg::this_grid(); grid.sync(); }
    const int lo = a.ph_lo, hi = a.ph_hi;
#define IN(k) (lo <= (k) && (k) < hi)
#define SEAM(k) do { if (IN(k) && IN((k) + 1)) { xcd_barrier(bar); } } while (0)
#ifndef RPT
#define RPT 0
#endif
#define NREP(k) ((((RPT) >> (k)) & 1) + 1)
    if (IN(0)) { for (int rep = 0; rep < NREP(0); ++rep) { __syncthreads(); p0_prologue(a, lds, wave, lane); } }
    SEAM(0);
    if ((RPT) & 256) { for (int i = 0; i < 8; ++i) { xcd_barrier(bar); } }
    if (IN(1)) {
        pg8::Gemm g{(const pg8::bf16_t*)(a.ws + WS_XN), (const pg8::bf16_t*)(a.ws + WS_WT), NTOK + NMEMTOK, NPAD + 512, 1024};
        pg8::ProjOrder S; S.init((int)gridDim.x, (int)blockIdx.x);
        pg8::EpiProj E{(pg8::bf16_t*)(a.ws + WS_PROJ), (pg8::bf16_t*)(a.ws + WS_KVM)};
        pg8::gemm_phase<pg8::EpiProj, pg8::ProjOrder, true, true>(lds, g, S, E);
        if (NREP(1) > 1) { __syncthreads(); pg8::gemm_phase<pg8::EpiProj, pg8::ProjOrder, true, true>(lds, g, S, E); }
    }
    SEAM(1);
    if (IN(2)) {
        for (int it = blockIdx.x; it < 1024 + 2048 + 256; it += gridDim.x) {
            if (it < 1024) { const int j = it >> 3, b = it & 7; for (int rep = 0; rep < NREP(2); ++rep) idx_unit(a, lds, b * 128 + (127 - j), wave, lane); }
            else if (it < 1024 + 2048) { for (int rep = 0; rep < NREP(3); ++rep) { __syncthreads(); attA_unit(a, lds, it - 1024, wave, lane); } }
            else { for (int rep = 0; rep < NREP(4); ++rep) { __syncthreads(); attM_unit(a, lds, it - 3072, wave, lane); } }
        }
    }
    SEAM(2);
    if (IN(3)) {
        for (int it = blockIdx.x; it < 256; it += gridDim.x) { const int j = it >> 3, b = it & 7; for (int rep = 0; rep < NREP(5); ++rep) attB_unit(a, lds, b * 32 + (31 - j), wave, lane); }
        for (int rep = 0; rep < NREP(6); ++rep) merge_rows(a, wave, lane);
    }
    SEAM(3);
    if (IN(4)) {
        pg8::Gemm g{(const pg8::bf16_t*)(a.ws + WS_OG), (const pg8::bf16_t*)(a.ws + WS_WOUT), NTOK, 1024, 1024};
        pg8::StaticOrder S; S.init(NTOK, 1024, (int)gridDim.x, (int)blockIdx.x);
        pg8::EpiRes E{a.x, a.out, (float*)(a.ws + WS_SS)};
        pg8::gemm_phase<pg8::EpiRes, pg8::StaticOrder, true, true>(lds, g, S, E);
    }
    SEAM(4);
    if (IN(5)) { final_norm(a, wave, lane); }
#undef IN
#undef SEAM
}

#ifndef N_LAUNCHES
#define N_LAUNCHES 1
#endif
extern "C" void kernel_launch(void* const* d_in, const int* in_sizes, int n_in, void* d_out, int out_size, void* d_ws, size_t ws_size, hipStream_t stream) {
    static int grid = 0;
    if (grid == 0) {
        if (n_in != 8 || out_size != NTOK * DMODEL || ws_size < WS_END) { fprintf(stderr, "kernel_launch: unexpected shapes (n_in %d out %d ws %zu)\n", n_in, out_size, ws_size); grid = -1; return; }
        int dev = 0, cus = 0, per_cu = 0;
        hipGetDevice(&dev); hipDeviceGetAttribute(&cus, hipDeviceAttributeMultiprocessorCount, dev);
        if (hipFuncSetAttribute((const void*)fwd_kernel, hipFuncAttributeMaxDynamicSharedMemorySize, LDS_BYTES) != hipSuccess) { fprintf(stderr, "kernel_launch: hipFuncSetAttribute failed\n"); grid = -1; return; }
        if (hipOccupancyMaxActiveBlocksPerMultiprocessor(&per_cu, (const void*)fwd_kernel, NWAVES * 64, LDS_BYTES) != hipSuccess || per_cu < 1) { fprintf(stderr, "kernel_launch: occupancy query says %d\n", per_cu); (void)hipGetLastError(); grid = -1; return; }
        grid = cus;
    }
    if (grid < 0) return;
    if (hipMemsetAsync((char*)d_ws + WS_BAR, 0, BAR_BYTES, stream) != hipSuccess) { fprintf(stderr, "kernel_launch: memset failed\n"); return; }
    Args a{};
    a.x = (const float*)d_in[0]; a.mem = (const float*)d_in[1]; a.g_in = (const float*)d_in[2]; a.g_mem = (const float*)d_in[3]; a.w_in = (const float*)d_in[4];
    a.w_mem = (const float*)d_in[5]; a.w_out = (const float*)d_in[6]; a.g_final = (const float*)d_in[7]; a.out = (float*)d_out; a.ws = (unsigned char*)d_ws;
    constexpr int NPH = 6;
    for (int li = 0; li < N_LAUNCHES; ++li) {
        a.ph_lo = (N_LAUNCHES == 1) ? 0 : li; a.ph_hi = (N_LAUNCHES == 1) ? NPH : li + 1;
        void* args[] = {&a};
        hipError_t e = hipLaunchCooperativeKernel((const void*)fwd_kernel, dim3(grid), dim3(NWAVES * 64), args, LDS_BYTES, stream);
        if (e != hipSuccess) { fprintf(stderr, "cooperative launch failed: %s (grid %d)\n", hipGetErrorString(e), grid); break; }
    }
}
```
